# Optimizing an MI355X kernel written in HIP

```python
import jax, jax.numpy as jnp
from jax import lax
import numpy as np

D_MODEL = 1024
BATCH = 32
SEQ = 256
DEPTH = 2
DEC_BATCH = 4
DEC_SEQ = 2048
PAST_LEN = 512

GRID_W = 64
MIX_W = D_MODEL
FOURIER_W = MIX_W // 2
FOURIER_HEADS = 4
FOURIER_HD = FOURIER_W // FOURIER_HEADS
GLA_DV_W = MIX_W - FOURIER_W
GLA_DK_W = GLA_DV_W // 2
GLA_HEADS = 4
DV = GLA_DV_W // GLA_HEADS
DK = GLA_DK_W // GLA_HEADS
GATE_RANK = 16
GATE_TEMP = 16.0
CHUNK = 64
D_FF = 11 * D_MODEL // 4
EPS = 1e-6
POS_BASE = 10000.0
S_F = FOURIER_W
S_Q = S_F + GLA_DK_W
S_K = S_Q + GLA_DK_W
S_V = S_K + GLA_DV_W
S_AF = S_V + GATE_RANK
S_AB = S_AF + GATE_RANK
IN_COLS = S_AB + GLA_DV_W

kernel_name = "hymba_fnet_gla_convffn_diffusion_step"


def rmsnorm(x, g):
    xf = x.astype(jnp.float32)
    y = xf * lax.rsqrt(jnp.mean(xf * xf, axis=-1, keepdims=True) + EPS)
    return (y * g.astype(jnp.float32)).astype(x.dtype)


def grid_pos_embed(rows, d):
    quarter = d // 4
    omega = 1.0 / (POS_BASE ** (jnp.arange(quarter, dtype=jnp.float32) / quarter))
    er = jnp.arange(rows, dtype=jnp.float32)[:, None] * omega
    ec = jnp.arange(GRID_W, dtype=jnp.float32)[:, None] * omega
    pr = jnp.concatenate([jnp.sin(er), jnp.cos(er)], axis=-1)
    pc = jnp.concatenate([jnp.sin(ec), jnp.cos(ec)], axis=-1)
    pe = jnp.concatenate([jnp.broadcast_to(pr[:, None], (rows, GRID_W, d // 2)),
                          jnp.broadcast_to(pc[None], (rows, GRID_W, d // 2))], axis=-1)
    return pe.reshape(rows * GRID_W, d)


def gla_chunk_scan(q, k, v, log_a, s0):
    B, H, T, _ = q.shape
    nc = T // CHUNK
    rs = lambda a: a.reshape(B, H, nc, CHUNK, a.shape[-1])
    q, k, v, log_a = rs(q), rs(k), rs(v), rs(log_a)
    b = jnp.cumsum(log_a, axis=3)
    b_last = b[:, :, :, -1:, :]
    q_t = q * jnp.exp(b)
    k_t = k * jnp.exp(-b)
    k_end = k * jnp.exp(b_last - b)
    mask = jnp.tril(jnp.ones((CHUNK, CHUNK), dtype=bool))
    att = jnp.where(mask, jnp.einsum('bhnid,bhnjd->bhnij', q_t, k_t), 0.0)
    o_intra = jnp.einsum('bhnij,bhnjv->bhniv', att, v)
    kv_chunk = jnp.einsum('bhnjd,bhnjv->bhndv', k_end, v)
    decay_chunk = jnp.exp(b_last[:, :, :, 0, :])

    def step(s, xs):
        dec, kv = xs
        return dec[..., None] * s + kv, s

    s_final, s_before = lax.scan(step, s0.astype(jnp.float32),
                                 (jnp.moveaxis(decay_chunk, 2, 0), jnp.moveaxis(kv_chunk, 2, 0)))
    s_before = jnp.moveaxis(s_before, 0, 2)
    o_inter = jnp.einsum('bhnid,bhndv->bhniv', q_t, s_before)
    return (o_intra + o_inter).reshape(B, H, T, DV), s_final


def token_mix(h, s0, lp):
    B, T, _ = h.shape
    z = h @ lp['w_in']
    zf, zq, zk, zv, zaf, zab, zg = jnp.split(
        z, (S_F, S_Q, S_K, S_V, S_AF, S_AB), axis=-1)
    zf = zf.reshape(B, T, FOURIER_HEADS, FOURIER_HD).astype(jnp.float32)
    yf = jnp.real(jnp.fft.fft2(zf, axes=(1, 3), norm='ortho')).reshape(B, T, FOURIER_W)
    heads = lambda a, d: a.astype(jnp.float32).reshape(B, T, GLA_HEADS, d).transpose(0, 2, 1, 3)
    q = heads(zq, DK) * (DK ** -0.5)
    k = heads(zk, DK)
    v = heads(zv, DV)
    la_f = heads(jax.nn.log_sigmoid((zaf @ lp['w_gate_f'] + lp['b_gate_f']).astype(jnp.float32)), DK) / GATE_TEMP
    la_b = heads(jax.nn.log_sigmoid((zab @ lp['w_gate_b'] + lp['b_gate_b']).astype(jnp.float32)), DK) / GATE_TEMP
    o_f, s_f = gla_chunk_scan(q, k, v, la_f, s0[:, 0])
    o_b, s_b = gla_chunk_scan(q[:, :, ::-1], k[:, :, ::-1], v[:, :, ::-1], la_b[:, :, ::-1], s0[:, 1])
    o = rmsnorm(o_f + o_b[:, :, ::-1], lp['g_gla'])
    o = o.transpose(0, 2, 1, 3).reshape(B, T, GLA_DV_W) * jax.nn.silu(zg.astype(jnp.float32))
    y = jnp.concatenate([yf, o], axis=-1).astype(h.dtype) @ lp['w_out']
    return y, jnp.stack([s_f, s_b], axis=1)


def conv_ffn(h, n_seg, lp):
    B, T, _ = h.shape
    u = (h @ lp['w_up']).reshape(B, n_seg, T // n_seg, 2 * D_FF)
    up = jnp.pad(u, ((0, 0), (0, 0), (1, 1), (0, 0)))
    cw = lp['conv_w']
    u = up[:, :, :-2] * cw[0] + up[:, :, 1:-1] * cw[1] + up[:, :, 2:] * cw[2] + lp['conv_b']
    val, gate = jnp.split(u.reshape(B, T, 2 * D_FF), 2, axis=-1)
    return (jax.nn.silu(gate) * val) @ lp['w_down']


def layer(x, mod, s0, n_seg, lp):
    shift_m, scale_m, gate_m, shift_f, scale_f, gate_f = jnp.split(mod, 6, axis=-1)
    h = rmsnorm(x, lp['g_pre_mix']) * (1.0 + scale_m) + shift_m
    o, s_fin = token_mix(h, s0, lp)
    x = x + gate_m * rmsnorm(o, lp['g_post_mix'])
    h = rmsnorm(x, lp['g_pre_ffn']) * (1.0 + scale_f) + shift_f
    x = x + gate_f * rmsnorm(conv_ffn(h, n_seg, lp), lp['g_post_ffn'])
    return x, s_fin


def setup_inputs(seed: int = 0) -> dict:
    key = jax.random.key(seed)
    ks = jax.random.split(key, 22)
    f32 = jnp.float32
    nrm = lambda k, shape, s: jax.random.normal(k, shape, f32) * s
    return {
        'x_prompt': nrm(ks[0], (BATCH, SEQ, D_MODEL), 1.0),
        'x_sample': nrm(ks[1], (DEC_BATCH, DEC_SEQ, D_MODEL), 1.0),
        'state_gla': nrm(ks[2], (DEC_BATCH, DEPTH, 2, GLA_HEADS, DK, DV), 1.0),
        'c': nrm(ks[3], (DEC_BATCH, D_MODEL), 1.0),
        'c_ctx': nrm(ks[4], (D_MODEL,), 1.0),
        'g_pre_mix': 1.0 + nrm(ks[5], (DEPTH, D_MODEL), 0.01),
        'g_post_mix': 1.0 + nrm(ks[6], (DEPTH, D_MODEL), 0.01),
        'g_pre_ffn': 1.0 + nrm(ks[7], (DEPTH, D_MODEL), 0.01),
        'g_post_ffn': 1.0 + nrm(ks[8], (DEPTH, D_MODEL), 0.01),
        'w_ada': nrm(ks[9], (DEPTH, D_MODEL, 6 * D_MODEL), 0.5 * D_MODEL ** -0.5),
        'b_ada': nrm(ks[10], (DEPTH, 6 * D_MODEL), 0.01),
        'w_in': nrm(ks[11], (DEPTH, D_MODEL, IN_COLS), D_MODEL ** -0.5),
        'w_gate_f': nrm(ks[12], (DEPTH, GATE_RANK, GLA_DK_W), GATE_RANK ** -0.5),
        'b_gate_f': nrm(ks[13], (DEPTH, GLA_DK_W), 0.5),
        'w_gate_b': nrm(ks[14], (DEPTH, GATE_RANK, GLA_DK_W), GATE_RANK ** -0.5),
        'b_gate_b': nrm(ks[15], (DEPTH, GLA_DK_W), 0.5),
        'g_gla': 1.0 + nrm(ks[16], (DEPTH, DV), 0.01),
        'w_out': nrm(ks[17], (DEPTH, MIX_W, D_MODEL), MIX_W ** -0.5),
        'w_up': nrm(ks[18], (DEPTH, D_MODEL, 2 * D_FF), D_MODEL ** -0.5),
        'conv_w': nrm(ks[19], (DEPTH, 3, 2 * D_FF), 3 ** -0.5),
        'conv_b': nrm(ks[20], (DEPTH, 2 * D_FF), 0.01),
        'w_down': nrm(ks[21], (DEPTH, D_FF, D_MODEL), D_FF ** -0.5),
    }


def reference(x_prompt, x_sample, state_gla, c, c_ctx, g_pre_mix, g_post_mix, g_pre_ffn,
              g_post_ffn, w_ada, b_ada, w_in, w_gate_f, b_gate_f, w_gate_b, b_gate_b, g_gla,
              w_out, w_up, conv_w, conv_b, w_down):
    def layer_params(l):
        return dict(g_pre_mix=g_pre_mix[l], g_post_mix=g_post_mix[l], g_pre_ffn=g_pre_ffn[l],
                    g_post_ffn=g_post_ffn[l], w_in=w_in[l], w_gate_f=w_gate_f[l],
                    b_gate_f=b_gate_f[l], w_gate_b=w_gate_b[l], b_gate_b=b_gate_b[l],
                    g_gla=g_gla[l], w_out=w_out[l], w_up=w_up[l], conv_w=conv_w[l],
                    conv_b=conv_b[l], w_down=w_down[l])

    xp = x_prompt
    s_zero = jnp.zeros((x_prompt.shape[0], 2, GLA_HEADS, DK, DV), jnp.float32)
    ctx_states = []
    for l in range(DEPTH):
        mod_ctx = (jax.nn.silu(c_ctx) @ w_ada[l] + b_ada[l])[None, None]
        xp, s_fin = layer(xp, mod_ctx, s_zero, 1, layer_params(l))
        ctx_states.append(s_fin)
    new_state_gla = jnp.stack(ctx_states, axis=1)

    rows = x_sample.shape[1] // GRID_W
    xs = x_sample + grid_pos_embed(rows, D_MODEL).astype(x_sample.dtype)[None]
    for l in range(DEPTH):
        mod = (jax.nn.silu(c) @ w_ada[l] + b_ada[l])[:, None]
        xs, _ = layer(xs, mod, state_gla[:, l], rows, layer_params(l))

    return (xp, xs, new_state_gla)
```

```cpp
#include <hip/hip_runtime.h>
#include <hip/hip_cooperative_groups.h>
#include <cstdio>
#include <cstdint>
namespace cg = cooperative_groups;

#define LAS __attribute__((address_space(3)))
typedef unsigned short bf16_t;
typedef short bf16x8 __attribute__((ext_vector_type(8)));
typedef float f32x4 __attribute__((ext_vector_type(4)));
typedef unsigned u32x4 __attribute__((ext_vector_type(4)));
typedef unsigned u32x2 __attribute__((ext_vector_type(2)));

constexpr int DM = 1024, MTOK = 16384, NCTX = 8192, DEPTH = 2;
constexpr int N1 = 2304;
constexpr int KOUT = 1536;
constexpr int DFF = 2816, NUP = 5632;
constexpr float EPS = 1e-6f;
constexpr size_t MiB = 1u << 20;
constexpr size_t WS_MOD = 0;
constexpr size_t MOD_BYTES = 2 * 5 * 6144 * 4;
constexpr size_t WS_BAR = 1 * MiB;
constexpr size_t WS_XCNT = 1 * MiB + 64 * 1024;
constexpr size_t WS_XBUF = 250 * MiB;
constexpr size_t WS_SSQ = 2 * MiB;
constexpr size_t WS_DEC = 3 * MiB;
constexpr size_t WS_WIN = 4 * MiB;
constexpr size_t WS_WOUT = 13 * MiB;
constexpr size_t WS_WUP = 19 * MiB;
constexpr size_t WS_WDN = 41 * MiB;
constexpr size_t WS_DS = 52 * MiB;
constexpr size_t WS_DC = 68 * MiB;
constexpr size_t WS_H = 70 * MiB;
constexpr size_t WS_ZT = 102 * MiB;
constexpr size_t WS_Q = 118 * MiB;
constexpr size_t WS_K = 126 * MiB;
constexpr size_t WS_V = 134 * MiB;
constexpr size_t WS_SG = 150 * MiB;
constexpr size_t WS_GATES = 166 * MiB;
constexpr size_t WS_A2 = 168 * MiB;
constexpr size_t WS_KV = 70 * MiB;
constexpr size_t WS_XRB = 216 * MiB;
constexpr size_t WS_Y1 = 102 * MiB;
constexpr size_t WS_ACT = 102 * MiB;
constexpr size_t WS_Y2 = 190 * MiB;
constexpr size_t WS_END = 254 * MiB;
constexpr int LDS_BYTES = 147456;
constexpr int MISC_OFF = 139264;
constexpr int XCH_OFF = 131072;

typedef __bf16 bf16x2_t __attribute__((ext_vector_type(2)));
typedef float f32x2_t __attribute__((ext_vector_type(2)));
__device__ __forceinline__ unsigned cvt_pk_bf16(float lo, float hi) { const f32x2_t v = {lo, hi}; const bf16x2_t b = __builtin_convertvector(v, bf16x2_t); return __builtin_bit_cast(unsigned, b); }
__device__ __forceinline__ float bf2f(unsigned h) { return __uint_as_float(h << 16); }
__device__ __forceinline__ float wave_sum(float v) {
#pragma unroll
    for (int o = 1; o < 64; o <<= 1) v += __shfl_xor(v, o);
    return v;
}
__device__ __forceinline__ float dpp_ror1(float v) { return __int_as_float(__builtin_amdgcn_update_dpp(__float_as_int(v), __float_as_int(v), 0x121, 0xf, 0xf, false)); }
__device__ __forceinline__ float dpp_rol1(float v) { return __int_as_float(__builtin_amdgcn_update_dpp(__float_as_int(v), __float_as_int(v), 0x12F, 0xf, 0xf, false)); }
__device__ __forceinline__ float dpp_swap1(float v) { return __int_as_float(__builtin_amdgcn_update_dpp(__float_as_int(v), __float_as_int(v), 0xB1, 0xf, 0xf, false)); }
__device__ __forceinline__ float silu_f(float x) { return x * __builtin_amdgcn_rcpf(1.0f + __expf(-x)); }

namespace pg8 {
constexpr int BM = 256, BK = 64, HALF = 128, HTB = HALF * BK * 2, NXCD = 8, WGM = 8;
__device__ __forceinline__ int lds_byte(int r, int c) { const int st = (r >> 4) * 2 + (c >> 5), rr = r & 15, cc = c & 31, ob = rr * 64 + cc * 2; return st * 1024 + (ob ^ (((ob >> 9) & 1) << 5)); }
__device__ __forceinline__ void stage_rc(int b, int& R, int& C) { const int st = b / 1024, sb = b % 1024, swz = sb ^ (((sb >> 9) & 1) << 5); R = (st >> 1) * 16 + swz / 64; C = (st & 1) * 32 + (swz % 64) / 2; }

struct Unit { const char* a; const char* b; char* o; int pm, pn; };
__device__ __forceinline__ const char* uni_ptr(const char* p) { const unsigned long long v = (unsigned long long)p; const unsigned lo = __builtin_amdgcn_readfirstlane((unsigned)v), hi = __builtin_amdgcn_readfirstlane((unsigned)(v >> 32)); return (const char*)(((unsigned long long)hi << 32) | lo); }

struct TileOrder {
    const char* A; const char* B; size_t a_tile, b_tile; int nM, nN, nwg, G, c;
    __device__ void init(const void* A_, const void* B_, int M, int N, int lda, int ldb, int G_, int c_) { A = (const char*)A_; B = (const char*)B_; a_tile = (size_t)256 * lda * 2; b_tile = (size_t)256 * ldb * 2; nM = M / BM; nN = N / BM; nwg = nM * nN; G = G_; c = c_; }
    __device__ bool next(int i, Unit& u) const {
        const long L = (long)i * G + c; if (L >= nwg) return false;
        int wgid = (int)L; { const int q = nwg / NXCD, r = nwg % NXCD, xcd = wgid % NXCD, off = wgid / NXCD; wgid = (xcd < r ? xcd * (q + 1) : r * (q + 1) + (xcd - r) * q) + off; }
        const int nig = WGM * nN, gid = wgid / nig, fm = gid * WGM, gsz = (nM - fm) < WGM ? (nM - fm) : WGM;
        u.pm = fm + ((wgid % nig) % gsz); u.pn = (wgid % nig) / gsz; u.a = A + (size_t)u.pm * a_tile; u.b = B + (size_t)u.pn * b_tile; u.o = nullptr; return true;
    }
};

template <class Epi, class Sched, bool ALIGN_EPI, int K, int LD>
__device__ __forceinline__ void gemm_phase(LAS unsigned char* lds, const int tid, const Sched& S, const Epi& E) {
    constexpr int lda = LD, ldb = LD;
    const int wid = __builtin_amdgcn_readfirstlane(tid >> 6), lane = tid & 63, wr = wid >> 2, wc = wid & 3, fr = lane & 15, fq = lane >> 4;
    constexpr int nt = K / BK;
    unsigned voffA[2];
#pragma unroll
    for (int i = 0; i < 2; ++i) { int R, C; stage_rc(tid * 16 + i * 8192, R, C); voffA[i] = (unsigned)(R * lda + C) * 2u; }
#define voffB voffA
    const size_t kstep = (size_t)(BK * 2);
    const size_t hstepA = (size_t)HALF * lda * 2, hstepB = (size_t)HALF * ldb * 2;
    const unsigned ldsw = (unsigned)wid * 1024u;
    const int aoff = lds_byte(wr * 64 + fr, fq * 8), boff = lds_byte(wc * 32 + fr, fq * 8);
#define PG8_SA(b, h) (((b) * 2 + (h)) * HTB)
#define PG8_SB(b, h) ((4 + (b) * 2 + (h)) * HTB)
#define PG8_STAGE(bufoff, gbase, voff) do { _Pragma("unroll") for (int _i = 0; _i < 2; ++_i) \
        __builtin_amdgcn_global_load_lds((const unsigned*)((const char*)(gbase) + (voff)[_i]), (LAS unsigned*)(lds + (bufoff) + ldsw + _i * 8192), 16, 0, 0); } while (0)
#define PG8_LDA(dst, b, h) do { _Pragma("unroll") for (int m = 0; m < 4; ++m) _Pragma("unroll") for (int k = 0; k < 2; ++k) dst[m][k] = *(const LAS bf16x8*)(lds + PG8_SA(b, h) + aoff + m * 2048 + k * 1024); } while (0)
#define PG8_LDB(dst, b, h) do { _Pragma("unroll") for (int n = 0; n < 2; ++n) _Pragma("unroll") for (int k = 0; k < 2; ++k) dst[n][k] = *(const LAS bf16x8*)(lds + PG8_SB(b, h) + boff + n * 2048 + k * 1024); } while (0)
#define PG8_MMA(ai, bj, At, Bt) do { __builtin_amdgcn_s_setprio(1); _Pragma("unroll") for (int m = 0; m < 4; ++m) _Pragma("unroll") for (int n = 0; n < 2; ++n) _Pragma("unroll") for (int k = 0; k < 2; ++k) \
        acc[ai][bj][m][n] = __builtin_amdgcn_mfma_f32_16x16x32_bf16(Bt[n][k], At[m][k], acc[ai][bj][m][n], 0, 0, 0); __builtin_amdgcn_s_setprio(0); } while (0)
#define PG8_WAIT_V(n) asm volatile("s_waitcnt vmcnt(" #n ")" ::: "memory")
#define PG8_WAIT_L(n) asm volatile("s_waitcnt lgkmcnt(" #n ")" ::: "memory")
#define PG8_BAR __builtin_amdgcn_s_barrier()
#define PG8_SCHED __builtin_amdgcn_sched_barrier(0)
    Unit cur, nxt; int ui = 0;
    if (!S.next(0, cur)) return;
    f32x4 acc[2][2][4][2];
#pragma unroll
    for (int a = 0; a < 2; ++a)
#pragma unroll
        for (int b = 0; b < 2; ++b)
#pragma unroll
            for (int m = 0; m < 4; ++m)
#pragma unroll
                for (int n = 0; n < 2; ++n) acc[a][b][m][n] = (f32x4){0.f, 0.f, 0.f, 0.f};
    bf16x8 At[4][2], B0[2][2], B1[2][2];
    const char* cA = uni_ptr(cur.a); const char* cB = uni_ptr(cur.b);
    PG8_STAGE(PG8_SB(0, 0), cB, voffB); PG8_STAGE(PG8_SB(0, 1), cB + hstepB, voffB); PG8_STAGE(PG8_SA(0, 0), cA, voffA); PG8_STAGE(PG8_SA(0, 1), cA + hstepA, voffA);
    if (wr == 1) PG8_BAR;
    PG8_WAIT_V(2); PG8_BAR;
    PG8_STAGE(PG8_SB(1, 0), cB + kstep, voffB); PG8_STAGE(PG8_SA(1, 0), cA + kstep, voffA); PG8_STAGE(PG8_SB(1, 1), cB + hstepB + kstep, voffB);
    PG8_WAIT_V(6); PG8_BAR;
    for (;;) {
        const bool has_next = S.next(ui + 1, nxt);
        const char* nA = uni_ptr(has_next ? nxt.a : cA); const char* nB = uni_ptr(has_next ? nxt.b : cB);
#pragma clang loop unroll(disable)
        for (int t = 0; t < nt; t += 2) {
            const bool last = (t == nt - 2);
            const char* a1 = cA + (size_t)(t + 1) * kstep;
            const char* a2 = last ? nA : cA + (size_t)(t + 2) * kstep; const char* b2 = last ? nB : cB + (size_t)(t + 2) * kstep;
            const char* a3 = a2 + kstep; const char* b3 = b2 + kstep;
            PG8_LDB(B0, 0, 0); PG8_LDB(B1, 0, 1); PG8_SCHED; PG8_LDA(At, 0, 0); PG8_STAGE(PG8_SA(1, 1), a1 + hstepA, voffA);
            PG8_WAIT_V(8); PG8_WAIT_L(0); PG8_BAR; PG8_MMA(0, 0, At, B0); PG8_MMA(0, 1, At, B1); PG8_BAR; PG8_SCHED;
            PG8_LDA(At, 0, 1); PG8_STAGE(PG8_SB(0, 0), b2, voffB); PG8_STAGE(PG8_SB(0, 1), b2 + hstepB, voffB); PG8_STAGE(PG8_SA(0, 0), a2, voffA);
            PG8_WAIT_V(8); PG8_WAIT_L(0); PG8_BAR; PG8_MMA(1, 0, At, B0); PG8_MMA(1, 1, At, B1); PG8_BAR; PG8_SCHED;
            PG8_LDB(B0, 1, 0); PG8_LDB(B1, 1, 1); PG8_SCHED; PG8_LDA(At, 1, 0); PG8_STAGE(PG8_SA(0, 1), a2 + hstepA, voffA);
            PG8_WAIT_V(8); PG8_WAIT_L(0); PG8_BAR; PG8_MMA(0, 0, At, B0); PG8_MMA(0, 1, At, B1); PG8_BAR; PG8_SCHED;
            PG8_LDA(At, 1, 1); PG8_STAGE(PG8_SB(1, 0), b3, voffB); PG8_STAGE(PG8_SB(1, 1), b3 + hstepB, voffB); PG8_STAGE(PG8_SA(1, 0), a3, voffA);
            PG8_WAIT_V(8); PG8_WAIT_L(0); PG8_BAR; PG8_MMA(1, 0, At, B0); PG8_MMA(1, 1, At, B1); PG8_BAR; PG8_SCHED;
        }
        if constexpr (ALIGN_EPI) { if (wr == 0) PG8_BAR; }
        E(acc, cur, wr, wc, fr, fq, lds, lane);
        if (!has_next) break;
#pragma unroll
        for (int a = 0; a < 2; ++a)
#pragma unroll
            for (int b = 0; b < 2; ++b)
#pragma unroll
                for (int m = 0; m < 4; ++m)
#pragma unroll
                    for (int n = 0; n < 2; ++n) acc[a][b][m][n] = (f32x4){0.f, 0.f, 0.f, 0.f};
        cur = nxt; cA = nA; cB = nB; ++ui;
        if constexpr (ALIGN_EPI) { if (wr == 1) PG8_BAR; }
    }
    PG8_WAIT_V(0);
    if constexpr (!ALIGN_EPI) { if (wr == 0) PG8_BAR; }
    PG8_BAR;
#undef voffB
#undef PG8_SA
#undef PG8_SB
#undef PG8_STAGE
#undef PG8_LDA
#undef PG8_LDB
#undef PG8_MMA
#undef PG8_WAIT_V
#undef PG8_WAIT_L
#undef PG8_BAR
#undef PG8_SCHED
}
}
typedef f32x4 AccT[2][2][4][2];

__host__ __device__ __forceinline__ int slot32(int x) { return 16 * ((x >> 2) & 1) + (x >> 3) * 4 + (x & 3); }
struct EpiIn {
    bf16_t *ZT, *Q, *Kb, *V, *SG; float* GATES;
    __device__ __forceinline__ void operator()(AccT& acc, const pg8::Unit& u, int wr, int wc, int fr, int fq, LAS unsigned char*, int) const {
        const int row0 = u.pm * 256 + wr * 64 + fr;
#pragma unroll
        for (int bj = 0; bj < 2; ++bj) {
            const int colb = u.pn * 256 + bj * 128 + wc * 32;
            if (colb < 512) {
                bf16_t* zt; int ldt, t0;
                if (u.pm < 32) { zt = ZT + (size_t)u.pm * 512 * 256; ldt = 256; t0 = 0; }
                else { const int q = u.pm - 32; zt = ZT + 4194304 + (size_t)(q >> 3) * 512 * 2048; ldt = 2048; t0 = (q & 7) * 256; }
#pragma unroll
                for (int n = 0; n < 2; ++n)
#pragma unroll
                    for (int ai = 0; ai < 2; ++ai)
#pragma unroll
                        for (int m = 0; m < 4; ++m) {
                            const int t = t0 + ai * 128 + wr * 64 + m * 16 + (fr & ~1); const f32x4 v = acc[ai][bj][m][n];
                            const bool odd = fr & 1;
                            const float s0 = odd ? v[0] : v[2], s1 = odd ? v[1] : v[3];
                            const float r0 = dpp_swap1(s0), r1 = dpp_swap1(s1);
                            const unsigned p0 = odd ? cvt_pk_bf16(r0, v[2]) : cvt_pk_bf16(v[0], r0);
                            const unsigned p1 = odd ? cvt_pk_bf16(r1, v[3]) : cvt_pk_bf16(v[1], r1);
                            const int xc = 8 * fq + 4 * n + (odd ? 2 : 0);
                            *(unsigned*)(zt + (size_t)(colb + slot32(xc)) * ldt + t) = p0; *(unsigned*)(zt + (size_t)(colb + slot32(xc + 1)) * ldt + t) = p1;
                        }
            } else {
                bf16_t* dst; int ld, c0; float sc = 1.f; bool act = false;
                if (colb < 768) { dst = Q; ld = 256; c0 = colb - 512; sc = 0.125f; }
                else if (colb < 1024) { dst = Kb; ld = 256; c0 = colb - 768; }
                else if (colb < 1536) { dst = V; ld = 512; c0 = colb - 1024; }
                else { dst = SG; ld = 512; c0 = colb - 1536; act = false; }
                c0 += 8 * fq;
#pragma unroll
                for (int ai = 0; ai < 2; ++ai)
#pragma unroll
                    for (int m = 0; m < 4; ++m) {
                        f32x4 v0 = acc[ai][bj][m][0] * sc, v1 = acc[ai][bj][m][1] * sc;
                        if (act) { v0[0] = silu_f(v0[0]); v0[1] = silu_f(v0[1]); v0[2] = silu_f(v0[2]); v0[3] = silu_f(v0[3]);
                                   v1[0] = silu_f(v1[0]); v1[1] = silu_f(v1[1]); v1[2] = silu_f(v1[2]); v1[3] = silu_f(v1[3]); }
                        u32x4 w; w.x = cvt_pk_bf16(v0[0], v0[1]); w.y = cvt_pk_bf16(v0[2], v0[3]); w.z = cvt_pk_bf16(v1[0], v1[1]); w.w = cvt_pk_bf16(v1[2], v1[3]);
                        *(u32x4*)(dst + (size_t)(row0 + ai * 128 + m * 16) * ld + c0) = w;
                    }
            }
        }
    }
};
__device__ __forceinline__ void gate_rows(LAS unsigned char* lds, int tid, int row0, const bf16_t* H, const bf16_t* Wa, float* GATES) {
    constexpr int RS = 1040;
    constexpr int ABUF = 64 * RS;
    const int wave = tid >> 6, lane = tid & 63, fr = lane & 15, fq = lane >> 4, rt = wave >> 1, ct = wave & 1;
    u32x4 ra[2][8], rw[2][4];
#pragma unroll
    for (int hf = 0; hf < 2; ++hf) {
#pragma unroll
        for (int i = 0; i < 8; ++i) { const int p = tid + 512 * i; ra[hf][i] = *(const u32x4*)(H + (size_t)(row0 + (p >> 6)) * 1024 + hf * 512 + (p & 63) * 8); }
#pragma unroll
        for (int i = 0; i < 4; ++i) { const int p = tid + 512 * i; rw[hf][i] = *(const u32x4*)(Wa + (size_t)(p >> 6) * 1024 + hf * 512 + (p & 63) * 8); }
    }
    f32x4 acc = {0.f, 0.f, 0.f, 0.f};
#pragma unroll
    for (int hf = 0; hf < 2; ++hf) {
        if (hf) __syncthreads();
#pragma unroll
        for (int i = 0; i < 8; ++i) { const int p = tid + 512 * i; *(LAS u32x4*)(lds + (p >> 6) * RS + (p & 63) * 16) = ra[hf][i]; }
#pragma unroll
        for (int i = 0; i < 4; ++i) { const int p = tid + 512 * i; *(LAS u32x4*)(lds + ABUF + (p >> 6) * RS + (p & 63) * 16) = rw[hf][i]; }
        __syncthreads();
#pragma unroll
        for (int kk = 0; kk < 16; ++kk) { const bf16x8 hv = *(const LAS bf16x8*)(lds + (rt * 16 + fr) * RS + kk * 64 + fq * 16), wv = *(const LAS bf16x8*)(lds + ABUF + (ct * 16 + fr) * RS + kk * 64 + fq * 16);
            acc = __builtin_amdgcn_mfma_f32_16x16x32_bf16(wv, hv, acc, 0, 0, 0); }
    }
    *(f32x4*)(GATES + (size_t)(row0 + rt * 16 + fr) * 32 + ct * 16 + fq * 4) = acc;
    __syncthreads();
}
struct EpiY {
    float* Y; float* SSQ;
    __device__ __forceinline__ void operator()(AccT& acc, const pg8::Unit& u, int wr, int wc, int fr, int fq, LAS unsigned char*, int) const {
        const int row0 = u.pm * 256 + wr * 64 + fr, col0 = u.pn * 256 + wc * 32 + 4 * fq;
#pragma unroll
        for (int ai = 0; ai < 2; ++ai)
#pragma unroll
            for (int m = 0; m < 4; ++m) {
                const int r = row0 + ai * 128 + m * 16; float s = 0.f;
#pragma unroll
                for (int bj = 0; bj < 2; ++bj)
#pragma unroll
                    for (int n = 0; n < 2; ++n) { const f32x4 v = acc[ai][bj][m][n]; s += (v[0] * v[0] + v[1] * v[1]) + (v[2] * v[2] + v[3] * v[3]);
                        *(f32x4*)(Y + (size_t)r * DM + col0 + bj * 128 + n * 16) = v; }
                s += __shfl_xor(s, 16); s += __shfl_xor(s, 32);
                if (fq == 0) SSQ[(size_t)r * 16 + u.pn * 4 + wc] = s;
            }
    }
};
struct EpiStore {
    static constexpr int ld = KOUT;
    __device__ __forceinline__ void operator()(AccT& acc, const pg8::Unit& u, int wr, int wc, int fr, int fq, LAS unsigned char*, int) const {
        bf16_t* o = (bf16_t*)u.o;
#pragma unroll
        for (int ai = 0; ai < 2; ++ai)
#pragma unroll
            for (int m = 0; m < 4; ++m) {
                const int r = ai * 128 + wr * 64 + m * 16 + fr;
#pragma unroll
                for (int bj = 0; bj < 2; ++bj) { const f32x4 v0 = acc[ai][bj][m][0], v1 = acc[ai][bj][m][1];
                    u32x4 w; w.x = cvt_pk_bf16(v0[0], v0[1]); w.y = cvt_pk_bf16(v0[2], v0[3]); w.z = cvt_pk_bf16(v1[0], v1[1]); w.w = cvt_pk_bf16(v1[2], v1[3]);
                    *(u32x4*)(o + (size_t)r * ld + bj * 128 + wc * 32 + 8 * fq) = w; }
            }
    }
};
struct EpiConv {
    bf16_t* ACT; const float* cw; const float* cb;
    __device__ __forceinline__ void operator()(AccT& acc, const pg8::Unit& u, int wr, int wc, int fr, int fq, LAS unsigned char* lds, int lane) const {
        int zo_ = 0; asm volatile("" : "+s"(zo_));
        LAS float* XB = (LAS float*)(lds + XCH_OFF + zo_);
        const bool is_ctx = u.pm < 32;
        (void)lane;
        const int cl0 = wc * 32 + 8 * fq;
        if (is_ctx) {
#pragma unroll
        for (int ai = 0; ai < 2; ++ai) { const int blk = 2 * ai + wr;
#pragma unroll
            for (int bj = 0; bj < 2; ++bj)
#pragma unroll
                for (int n = 0; n < 2; ++n) { const int cl = cl0 + 4 * n;
                    if (fr == 0) *(LAS f32x4*)(XB + ((blk * 2 + 0) * 2 + bj) * 128 + cl) = acc[ai][bj][0][n];
                    if (fr == 15) *(LAS f32x4*)(XB + ((blk * 2 + 1) * 2 + bj) * 128 + cl) = acc[ai][bj][3][n]; } }
        asm volatile("s_waitcnt lgkmcnt(0)" ::: "memory"); __builtin_amdgcn_s_barrier(); asm volatile("" ::: "memory");
        }
        f32x4 w0[2][2], w1[2][2]; u32x2 w2p[2][2], bbp[2][2];
#pragma unroll
        for (int n = 0; n < 2; ++n)
#pragma unroll
            for (int bj = 0; bj < 2; ++bj) { const int gc = bj * DFF + u.pn * 128 + cl0 + 4 * n;
                w0[n][bj] = *(const f32x4*)(cw + gc); w1[n][bj] = *(const f32x4*)(cw + NUP + gc); { const f32x4 t4 = *(const f32x4*)(cw + 2 * NUP + gc); w2p[n][bj].x = cvt_pk_bf16(t4[0], t4[1]); w2p[n][bj].y = cvt_pk_bf16(t4[2], t4[3]); }
                const f32x4 b4 = *(const f32x4*)(cb + gc); bbp[n][bj].x = cvt_pk_bf16(b4[0], b4[1]); bbp[n][bj].y = cvt_pk_bf16(b4[2], b4[3]); }
#pragma unroll
        for (int ai = 0; ai < 2; ++ai) { const int blk = 2 * ai + wr;
#pragma unroll
            for (int m = 0; m < 4; ++m) {
                unsigned pq[2][2];
#pragma unroll
                for (int n = 0; n < 2; ++n) {
                    f32x4 cv[2];
#pragma unroll
                    for (int bj = 0; bj < 2; ++bj) {
                        const f32x4 cur = acc[ai][bj][m][n]; f32x4 up, dn;
                        f32x4 eu = {0.f, 0.f, 0.f, 0.f}, ed = {0.f, 0.f, 0.f, 0.f};
                        if (m == 0 && is_ctx && blk > 0) eu = *(LAS f32x4*)(XB + (((blk - 1) * 2 + 1) * 2 + bj) * 128 + cl0 + 4 * n);
                        if (m == 3 && is_ctx && blk < 3) ed = *(LAS f32x4*)(XB + (((blk + 1) * 2 + 0) * 2 + bj) * 128 + cl0 + 4 * n);
#pragma unroll
                        for (int j = 0; j < 4; ++j) {
                            const float su = (fr == 15 && m > 0) ? acc[ai][bj][m > 0 ? m - 1 : 0][n][j] : cur[j];
                            const float sd = (fr == 0 && m < 3) ? acc[ai][bj][m < 3 ? m + 1 : 3][n][j] : cur[j];
                            float u_ = dpp_ror1(su), d_ = dpp_rol1(sd);
                            if (m == 0) u_ = (fr == 0) ? eu[j] : u_;
                            if (m == 3) d_ = (fr == 15) ? ed[j] : d_;
                            up[j] = u_; dn[j] = d_;
                        }
                        const u32x2 bp = bbp[n][bj];
                        const f32x4 bb = {bf2f(bp.x & 0xffffu), bf2f(bp.x >> 16), bf2f(bp.y & 0xffffu), bf2f(bp.y >> 16)};
                        const u32x2 wp = w2p[n][bj];
                        const f32x4 w2 = {bf2f(wp.x & 0xffffu), bf2f(wp.x >> 16), bf2f(wp.y & 0xffffu), bf2f(wp.y >> 16)};
                        cv[bj] = w0[n][bj] * up + w1[n][bj] * cur + w2 * dn + bb;
                    }
                    const unsigned p0 = cvt_pk_bf16(silu_f(cv[1][0]) * cv[0][0], silu_f(cv[1][1]) * cv[0][1]), p1 = cvt_pk_bf16(silu_f(cv[1][2]) * cv[0][2], silu_f(cv[1][3]) * cv[0][3]);
                    pq[n][0] = p0; pq[n][1] = p1;
                }
                const u32x4 w4 = {pq[0][0], pq[0][1], pq[1][0], pq[1][1]};
                *(u32x4*)(ACT + (size_t)(u.pm * 256 + ai * 128 + wr * 64 + m * 16 + fr) * DFF + u.pn * 128 + cl0) = w4;
            }
        }
    }
};
#define RLX_AGENT __ATOMIC_RELAXED, __HIP_MEMORY_SCOPE_AGENT
__device__ __forceinline__ void panel_exchange(const float (&ps)[2][4], float (&rs)[2][4], int wr, int wc, int fr, int fq, int tid, LAS unsigned char* lds, unsigned* xslot, unsigned* cnt, int pn) {
    LAS float* P = (LAS float*)(lds + XCH_OFF); LAS float* S = (LAS float*)(lds + XCH_OFF + 4096);
#pragma unroll
    for (int ai = 0; ai < 2; ++ai)
#pragma unroll
        for (int m = 0; m < 4; ++m) if (fq == 0) P[(ai * 128 + wr * 64 + m * 16 + fr) * 4 + wc] = ps[ai][m];
    asm volatile("s_waitcnt lgkmcnt(0)" ::: "memory"); __builtin_amdgcn_s_barrier(); asm volatile("" ::: "memory");
    if (tid < 256) { const f32x4 p = *(const LAS f32x4*)(P + tid * 4); __hip_atomic_store(xslot + pn * 256 + tid, __float_as_uint((p[0] + p[1]) + (p[2] + p[3])), RLX_AGENT); }
    asm volatile("s_waitcnt vmcnt(0) lgkmcnt(0)" ::: "memory"); __builtin_amdgcn_s_barrier(); asm volatile("" ::: "memory");
    if (tid == 0) { __hip_atomic_fetch_add(cnt, 1u, RLX_AGENT); unsigned sp = 0;
        while (__hip_atomic_load(cnt, RLX_AGENT) < 4u) { __builtin_amdgcn_s_sleep(1); if (++sp > (1u << 22)) break; }
        __builtin_amdgcn_fence(__ATOMIC_ACQUIRE, "agent"); }
    asm volatile("s_waitcnt vmcnt(0) lgkmcnt(0)" ::: "memory"); __builtin_amdgcn_s_barrier(); asm volatile("" ::: "memory");
    if (tid < 256) { float t = 0.f;
#pragma unroll
        for (int q = 0; q < 4; ++q) t += __uint_as_float(__hip_atomic_load(xslot + q * 256 + tid, RLX_AGENT));
        S[tid] = __builtin_amdgcn_rsqf(t * (1.f / 1024.f) + EPS); }
    asm volatile("s_waitcnt vmcnt(0) lgkmcnt(0)" ::: "memory"); __builtin_amdgcn_s_barrier(); asm volatile("" ::: "memory");
#pragma unroll
    for (int ai = 0; ai < 2; ++ai)
#pragma unroll
        for (int m = 0; m < 4; ++m) rs[ai][m] = S[ai * 128 + wr * 64 + m * 16 + fr];
}
__device__ __forceinline__ void row_ssq(const AccT& acc, float (&ps)[2][4]) {
#pragma unroll
    for (int ai = 0; ai < 2; ++ai)
#pragma unroll
        for (int m = 0; m < 4; ++m) { float s = 0.f;
#pragma unroll
            for (int bj = 0; bj < 2; ++bj)
#pragma unroll
                for (int n = 0; n < 2; ++n) { const f32x4 v = acc[ai][bj][m][n]; s += (v[0] * v[0] + v[1] * v[1]) + (v[2] * v[2] + v[3] * v[3]); }
            s += __shfl_xor(s, 16); s += __shfl_xor(s, 32); ps[ai][m] = s; }
}
struct EpiRows {
    float* OUTF; bf16_t* XB; bf16_t* H; const float* MOD; const float* g_post; const float* g_pre;
    int l_gate, slot_gate, l_h, slot_scale, slot_shift; bool do_h;
    unsigned* xbuf; unsigned* cnt;
    __device__ __forceinline__ void operator()(AccT& acc, const pg8::Unit& u, int wr, int wc, int fr, int fq, LAS unsigned char* lds, int lane) const {
        const int tid = (wr * 4 + wc) * 64 + lane;
        const int cond = u.pm < 32 ? 0 : 1 + ((u.pm - 32) >> 3);
        const int row0 = u.pm * 256 + wr * 64 + fr, col0 = u.pn * 256 + wc * 32 + 8 * fq;
        float ps[2][4], rs[2][4];
        row_ssq(acc, ps);
        panel_exchange(ps, rs, wr, wc, fr, fq, tid, lds, xbuf + (size_t)(0 * 64 + u.pm) * 1024, cnt + (0 * 64 + u.pm) * 64, u.pn);
        const float* gatev = MOD + (size_t)((l_gate * 5 + cond) * 6 + slot_gate) * 1024;
#pragma unroll
        for (int bj = 0; bj < 2; ++bj) { const int c = col0 + bj * 128;
            const f32x4 gg0 = *(const f32x4*)(gatev + c) * *(const f32x4*)(g_post + c), gg1 = *(const f32x4*)(gatev + c + 4) * *(const f32x4*)(g_post + c + 4);
#pragma unroll
            for (int ai = 0; ai < 2; ++ai)
#pragma unroll
                for (int m = 0; m < 4; ++m) { const size_t off = (size_t)(row0 + ai * 128 + m * 16) * DM + c;
                    const u32x4 xb = *(const u32x4*)(XB + off);
                    const f32x4 xo0 = {bf2f(xb.x & 0xffffu), bf2f(xb.x >> 16), bf2f(xb.y & 0xffffu), bf2f(xb.y >> 16)};
                    const f32x4 xo1 = {bf2f(xb.z & 0xffffu), bf2f(xb.z >> 16), bf2f(xb.w & 0xffffu), bf2f(xb.w >> 16)};
                    const f32x4 xn0 = xo0 + gg0 * (acc[ai][bj][m][0] * rs[ai][m]), xn1 = xo1 + gg1 * (acc[ai][bj][m][1] * rs[ai][m]);
                    acc[ai][bj][m][0] = xn0; acc[ai][bj][m][1] = xn1;
                    if (OUTF) { *(f32x4*)(OUTF + off) = xn0; *(f32x4*)(OUTF + off + 4) = xn1; }
                    else { u32x4 w; w.x = cvt_pk_bf16(xn0[0], xn0[1]); w.y = cvt_pk_bf16(xn0[2], xn0[3]); w.z = cvt_pk_bf16(xn1[0], xn1[1]); w.w = cvt_pk_bf16(xn1[2], xn1[3]); *(u32x4*)(XB + off) = w; } } }
        if (do_h) {
            row_ssq(acc, ps);
            panel_exchange(ps, rs, wr, wc, fr, fq, tid, lds, xbuf + (size_t)(1 * 64 + u.pm) * 1024, cnt + (1 * 64 + u.pm) * 64, u.pn);
            const float* mb = MOD + (size_t)((l_h * 5 + cond) * 6) * 1024;
#pragma unroll
            for (int bj = 0; bj < 2; ++bj) { const int c = col0 + bj * 128;
                const f32x4 gs0 = *(const f32x4*)(g_pre + c) * (*(const f32x4*)(mb + slot_scale * 1024 + c) + 1.0f), sh0 = *(const f32x4*)(mb + slot_shift * 1024 + c);
                const f32x4 gs1 = *(const f32x4*)(g_pre + c + 4) * (*(const f32x4*)(mb + slot_scale * 1024 + c + 4) + 1.0f), sh1 = *(const f32x4*)(mb + slot_shift * 1024 + c + 4);
#pragma unroll
                for (int ai = 0; ai < 2; ++ai)
#pragma unroll
                    for (int m = 0; m < 4; ++m) { const f32x4 h0 = acc[ai][bj][m][0] * rs[ai][m] * gs0 + sh0, h1 = acc[ai][bj][m][1] * rs[ai][m] * gs1 + sh1;
                        u32x4 w; w.x = cvt_pk_bf16(h0[0], h0[1]); w.y = cvt_pk_bf16(h0[2], h0[3]); w.z = cvt_pk_bf16(h1[0], h1[1]); w.w = cvt_pk_bf16(h1[2], h1[3]);
                        *(u32x4*)(H + (size_t)(row0 + ai * 128 + m * 16) * DM + c) = w; } }
        }
    }
};
struct DftOrder {
    const char *D, *ZT; char* A2; int G, c; bool smp;
    __device__ bool next(int i, pg8::Unit& u) const {
        const int L = i * G + c; if (L >= 128) return false;
        if (smp) { const int b = L >> 5, mt = (L >> 1) & 15, nt = L & 1;
            u.a = D + (size_t)mt * 256 * 2048 * 2; u.b = ZT + ((size_t)(b * 512 + nt * 256) * 2048) * 2;
            u.o = A2 + ((size_t)(NCTX + b * 2048 + (mt & 7) * 256) * KOUT + (mt >> 3) * 512 + nt * 256) * 2; u.pm = mt; u.pn = nt; }
        else { const int b = L >> 2, mt = (L >> 1) & 1, nt = L & 1;
            u.a = D + (size_t)mt * 256 * 256 * 2; u.b = ZT + ((size_t)(b * 512 + nt * 256) * 256) * 2;
            u.o = A2 + ((size_t)(b * 256) * KOUT + mt * 512 + nt * 256) * 2; u.pm = mt; u.pn = nt; }
        return true;
    }
};

struct Args { const float* in[22]; float* out; unsigned char* ws; int ph_lo, ph_hi; };
struct Frame {
    LAS unsigned char* lds; int tid, lane, wave, G, bid;
    const float* const* in; float* out; unsigned char* ws;
};
#define IN_XP 0
#define IN_XS 1
#define IN_STATE 2
#define IN_C 3
#define IN_CCTX 4
#define IN_GPM 5
#define IN_GQM 6
#define IN_GPF 7
#define IN_GQF 8
#define IN_WADA 9
#define IN_BADA 10
#define IN_WIN 11
#define IN_WGF 12
#define IN_BGF 13
#define IN_WGB 14
#define IN_BGB 15
#define IN_GGLA 16
#define IN_WOUT 17
#define IN_WUP 18
#define IN_CW 19
#define IN_CB 20
#define IN_WDN 21

__device__ __forceinline__ void transpose_item(const float* W, int ldw, int nblk, bf16_t* WT, int ldt, int koff, int mode, LAS float* scr, int item, int lane) {
    const int kb = item / nblk, nb = item % nblk, k0 = 64 * kb, n0 = 32 * nb;
#pragma unroll 8
    for (int i = 0; i < 32; ++i) { const int kk = 2 * i + (lane >> 5); scr[kk * 33 + (lane & 31)] = W[(size_t)(k0 + kk) * ldw + n0 + (lane & 31)]; }
    asm volatile("s_waitcnt lgkmcnt(0)" ::: "memory");
    const int c = lane & 7;
#pragma unroll
    for (int j = 0; j < 4; ++j) { const int n = (lane >> 3) + 8 * j; const LAS float* s = scr + (8 * c) * 33 + n;
        u32x4 o; o.x = cvt_pk_bf16(s[0 * 33], s[1 * 33]); o.y = cvt_pk_bf16(s[2 * 33], s[3 * 33]); o.z = cvt_pk_bf16(s[4 * 33], s[5 * 33]); o.w = cvt_pk_bf16(s[6 * 33], s[7 * 33]);
        int nn = n0 + n, drow = nn;
        if (mode == 1) { const int g = nn >= DFF ? 1 : 0, jj = nn - g * DFF; drow = (jj >> 7) * 256 + g * 128 + (jj & 127);
            const int x = drow & 31; drow = (drow & ~31) + 16 * ((x >> 2) & 1) + (x >> 3) * 4 + (x & 3); }
        if (mode == 3) { const int x = nn & 31; drow = (nn & ~31) + 16 * ((x >> 2) & 1) + (x >> 3) * 4 + (x & 3); }
        if (mode == 2) { drow = nn < 1536 ? nn : (nn < 1568 ? 2048 + (nn - 1536) : nn - 32);
            if (drow < 2048) { const int x = drow & 31; drow = (drow & ~31) + 16 * ((x >> 2) & 1) + (x >> 3) * 4 + (x & 3); } }
        *(u32x4*)(WT + (size_t)drow * ldt + koff + k0 + 8 * c) = o; }
    asm volatile("s_waitcnt lgkmcnt(0)" ::: "memory");
}

__device__ __forceinline__ void prep_conv_item(const Frame& F, int it, LAS float* scr, const LAS float* TAB) {
    bf16_t* Win_t = (bf16_t*)(F.ws + WS_WIN); bf16_t* Wout_t = (bf16_t*)(F.ws + WS_WOUT); bf16_t* Wup_t = (bf16_t*)(F.ws + WS_WUP); bf16_t* Wdn_t = (bf16_t*)(F.ws + WS_WDN);
    bf16_t* DS = (bf16_t*)(F.ws + WS_DS); bf16_t* DC = (bf16_t*)(F.ws + WS_DC);
    constexpr int I_IN = 16 * 65, I_PAD = 224, I_UP = 16 * 176, I_DN = 44 * 32, I_OG = 8 * 32, I_FOLD = 4 * 16 * 16;
    constexpr int PER_L = I_IN + I_PAD + I_UP + I_DN + I_OG + I_FOLD;
    constexpr int I_DSM = 4096 * 4, I_DCM = 256;
    constexpr int NITEMS = 2 * PER_L + I_DSM + I_DCM;
    int r = it;
        if (r < 2 * PER_L) {
            const int l = r / PER_L; r -= l * PER_L;
            if (r < I_IN) { transpose_item(F.in[IN_WIN] + (size_t)l * 1024 * 2080, 2080, 65, Win_t + (size_t)l * N1 * 1024, 1024, 0, 2, scr, r, F.lane); return; } r -= I_IN;
            if (r < I_PAD) { u32x4 z = {0u, 0u, 0u, 0u}; u32x4* p = (u32x4*)(Win_t + ((size_t)l * N1 + 2080 + r) * 1024); p[F.lane] = z; p[64 + F.lane] = z; return; } r -= I_PAD;
            if (r < I_UP) { transpose_item(F.in[IN_WUP] + (size_t)l * 1024 * NUP, NUP, 176, Wup_t + (size_t)l * NUP * 1024, 1024, 0, 1, scr, r, F.lane); return; } r -= I_UP;
            if (r < I_DN) { transpose_item(F.in[IN_WDN] + (size_t)l * DFF * 1024, 1024, 32, Wdn_t + (size_t)l * 1024 * DFF, DFF, 0, 3, scr, r, F.lane); return; } r -= I_DN;
            if (r < I_OG) { transpose_item(F.in[IN_WOUT] + ((size_t)l * 1024 + 512) * 1024, 1024, 32, Wout_t + (size_t)l * 1024 * KOUT, KOUT, 1024, 3, scr, r, F.lane); return; } r -= I_OG;
            {
                const int h = r >> 8, cbk = (r >> 4) & 15, nb = r & 15, n = nb * 64 + F.lane;
                const float* wp = F.in[IN_WOUT] + ((size_t)l * 1024 + h * 128) * 1024 + n;
                float ac[8], as[8];
#pragma unroll
                for (int e = 0; e < 8; ++e) { ac[e] = 0.f; as[e] = 0.f; }
#pragma unroll 16
                for (int cp = 0; cp < 128; ++cp) { const float w = wp[(size_t)cp * 1024];
#pragma unroll
                    for (int e = 0; e < 8; ++e) { const int idx = ((cbk * 8 + e) * cp) & 127; ac[e] += TAB[idx] * w; as[e] += TAB[128 + idx] * w; } }
                const float sc = 0.08838834764831845f;
                u32x4 oc, os;
                oc.x = cvt_pk_bf16(ac[0] * sc, ac[1] * sc); oc.y = cvt_pk_bf16(ac[2] * sc, ac[3] * sc); oc.z = cvt_pk_bf16(ac[4] * sc, ac[5] * sc); oc.w = cvt_pk_bf16(ac[6] * sc, ac[7] * sc);
                os.x = cvt_pk_bf16(-as[0] * sc, -as[1] * sc); os.y = cvt_pk_bf16(-as[2] * sc, -as[3] * sc); os.z = cvt_pk_bf16(-as[4] * sc, -as[5] * sc); os.w = cvt_pk_bf16(-as[6] * sc, -as[7] * sc);
                const int xn_ = n & 31, nrow = (n & ~31) + 16 * ((xn_ >> 2) & 1) + (xn_ >> 3) * 4 + (xn_ & 3);
                bf16_t* dst = Wout_t + ((size_t)l * 1024 + nrow) * KOUT + h * 128 + cbk * 8;
                *(u32x4*)dst = oc; *(u32x4*)(dst + 512) = os;
            }
            return;
        }
        r -= 2 * PER_L;
        if (r < I_DSM) { const int m = r >> 2, k0 = (r & 3) * 512 + F.lane * 8, part = m >> 11, tp = m & 2047; float v[8];
#pragma unroll
            for (int e = 0; e < 8; ++e) { const float x = (float)((tp * (k0 + e)) & 2047) * (1.f / 2048.f); v[e] = (part ? __builtin_amdgcn_sinf(x) : __builtin_amdgcn_cosf(x)) * 0.022097086912079608f; }
            u32x4 o; o.x = cvt_pk_bf16(v[0], v[1]); o.y = cvt_pk_bf16(v[2], v[3]); o.z = cvt_pk_bf16(v[4], v[5]); o.w = cvt_pk_bf16(v[6], v[7]);
            *(u32x4*)(DS + (size_t)m * 2048 + k0) = o; return; }
        r -= I_DSM;
        { const int m = r * 2 + (F.lane >> 5), k0 = (F.lane & 31) * 8, part = m >> 8, tp = m & 255; float v[8];
#pragma unroll
            for (int e = 0; e < 8; ++e) { const float x = (float)((tp * (k0 + e)) & 255) * (1.f / 256.f); v[e] = (part ? __builtin_amdgcn_sinf(x) : __builtin_amdgcn_cosf(x)) * 0.0625f; }
            u32x4 o; o.x = cvt_pk_bf16(v[0], v[1]); o.y = cvt_pk_bf16(v[2], v[3]); o.z = cvt_pk_bf16(v[4], v[5]); o.w = cvt_pk_bf16(v[6], v[7]);
            *(u32x4*)(DC + (size_t)m * 256 + k0) = o; }
    }

__device__ __forceinline__ void row0_item(const Frame& F, int r) {
    const float* MOD = (const float*)(F.ws + WS_MOD); bf16_t* H = (bf16_t*)(F.ws + WS_H);
    const int cond = r < NCTX ? 0 : 1 + ((r - NCTX) >> 11);
    f32x4 x[4];
    const f32x4* src = (const f32x4*)(r < NCTX ? F.in[IN_XP] + (size_t)r * DM : F.in[IN_XS] + (size_t)(r - NCTX) * DM) + F.lane;
#pragma unroll
    for (int j = 0; j < 4; ++j) x[j] = src[64 * j];
    if (r >= NCTX) { const int t = (r - NCTX) & 2047; const float pr = (float)(t >> 6), pc = (float)(t & 63);
#pragma unroll
        for (int k = 0; k < 4; ++k) { const float q = (float)(4 * F.lane + k); const float om = __builtin_amdgcn_exp2f(q * (-13.287712379549449f / 256.f)) * 0.15915494309189535f;
            const float ar = pr * om, ac = pc * om;
            x[0][k] += __builtin_amdgcn_sinf(ar - floorf(ar)); x[1][k] += __builtin_amdgcn_cosf(ar - floorf(ar));
            x[2][k] += __builtin_amdgcn_sinf(ac - floorf(ac)); x[3][k] += __builtin_amdgcn_cosf(ac - floorf(ac)); } }
    { u32x2* xo = (u32x2*)((bf16_t*)(F.ws + WS_XRB) + (size_t)r * DM) + F.lane;
#pragma unroll
      for (int j = 0; j < 4; ++j) { u32x2 w; w.x = cvt_pk_bf16(x[j][0], x[j][1]); w.y = cvt_pk_bf16(x[j][2], x[j][3]); xo[64 * j] = w; } }
    float ss = 0.f;
#pragma unroll
    for (int j = 0; j < 4; ++j) ss += (x[j][0] * x[j][0] + x[j][1] * x[j][1]) + (x[j][2] * x[j][2] + x[j][3] * x[j][3]);
    const float rx = __builtin_amdgcn_rsqf(wave_sum(ss) * (1.f / 1024.f) + EPS);
    const float* mb = MOD + (size_t)cond * 6144;
    const f32x4* shp = (const f32x4*)mb + F.lane; const f32x4* scp = (const f32x4*)(mb + 1024) + F.lane; const f32x4* gp = (const f32x4*)F.in[IN_GPM] + F.lane;
    u32x2* ho = (u32x2*)(H + (size_t)r * DM) + F.lane;
#pragma unroll
    for (int j = 0; j < 4; ++j) { const f32x4 hv = x[j] * rx * gp[64 * j] * (scp[64 * j] + 1.0f) + shp[64 * j];
        u32x2 w; w.x = cvt_pk_bf16(hv[0], hv[1]); w.y = cvt_pk_bf16(hv[2], hv[3]); ho[64 * j] = w; }
}

__device__ __forceinline__ void prep_gemv(const Frame& F) {
    LAS float* SC = (LAS float*)(F.lds + 72 * 1024);
    LAS float* RED = (LAS float*)(F.lds + 92 * 1024);
    LAS float* TAB = (LAS float*)(F.lds + 104 * 1024);
    const float* c = F.in[IN_C]; const float* cctx = F.in[IN_CCTX];
    for (int e = F.tid; e < 5120; e += 512) { const float v = e < 1024 ? cctx[e] : c[e - 1024]; SC[e] = silu_f(v); }
    if (F.tid < 128) { TAB[F.tid] = __builtin_amdgcn_cosf((float)F.tid * (1.f / 128.f)); TAB[128 + F.tid] = __builtin_amdgcn_sinf((float)F.tid * (1.f / 128.f)); }
    __syncthreads();
    float* MOD = (float*)(F.ws + WS_MOD);
    for (int it = F.bid; it < 384; it += F.G) {
        const int l = it / 192, cbk = it % 192;
        const int cl = F.lane & 31, kh = F.lane >> 5, col = cbk * 32 + cl, kbase = F.wave * 128 + kh * 64;
        const float* wp = F.in[IN_WADA] + ((size_t)l * 1024 + kbase) * 6144 + col;
        float a0 = 0.f, a1 = 0.f, a2 = 0.f, a3 = 0.f, a4 = 0.f;
#pragma unroll 16
        for (int kk = 0; kk < 64; ++kk) { const float w = wp[(size_t)kk * 6144]; const int k = kbase + kk;
            a0 += SC[k] * w; a1 += SC[1024 + k] * w; a2 += SC[2048 + k] * w; a3 += SC[3072 + k] * w; a4 += SC[4096 + k] * w; }
        const int slot = F.wave * 2 + kh;
        RED[(slot * 5 + 0) * 32 + cl] = a0; RED[(slot * 5 + 1) * 32 + cl] = a1; RED[(slot * 5 + 2) * 32 + cl] = a2;
        RED[(slot * 5 + 3) * 32 + cl] = a3; RED[(slot * 5 + 4) * 32 + cl] = a4;
        __syncthreads();
        if (F.tid < 160) { const int cnd = F.tid >> 5, ln = F.tid & 31; float s = 0.f;
#pragma unroll
            for (int w = 0; w < 16; ++w) s += RED[(w * 5 + cnd) * 32 + ln];
            const int cc = cbk * 32 + ln;
            MOD[(size_t)(l * 5 + cnd) * 6144 + cc] = s + F.in[IN_BADA][l * 6144 + cc]; }
        __syncthreads();
    }
}

__device__ __forceinline__ void prep_rest(const Frame& F) {
    LAS float* TAB = (LAS float*)(F.lds + 104 * 1024);
    if (F.tid < 128) { TAB[F.tid] = __builtin_amdgcn_cosf((float)F.tid * (1.f / 128.f)); TAB[128 + F.tid] = __builtin_amdgcn_sinf((float)F.tid * (1.f / 128.f)); }
    __syncthreads();
    LAS float* scr = (LAS float*)(F.lds + F.wave * 8448);
    const int gw = F.bid * 8 + F.wave, NGW = F.G * 8;
    constexpr int NCONV = 30176;
    int cidx = 0, ridx = 0;
    for (int k = 0; ; ++k) {
        const int rr = ridx * NGW + gw, it = cidx * NGW + gw;
        if ((k % 3 == 2 || it >= NCONV) && rr < MTOK) { row0_item(F, rr); ++ridx; continue; }
        if (it < NCONV) { prep_conv_item(F, it, scr, TAB); ++cidx; continue; }
        break;
    }
}

__device__ __forceinline__ void row_phase(const Frame& F, int l, int kind, const float* Y) {
    const float* MOD = (const float*)(F.ws + WS_MOD); const float* SSQ = (const float*)(F.ws + WS_SSQ);
    bf16_t* H = (bf16_t*)(F.ws + WS_H); float* XR = F.out;
    const int gw = F.bid * 8 + F.wave, NGW = F.G * 8;
    for (int r = gw; r < MTOK; r += NGW) {
        const int cond = r < NCTX ? 0 : 1 + ((r - NCTX) >> 11);
        f32x4 x[4];
        if (kind == 0) {
            const f32x4* src = (const f32x4*)(r < NCTX ? F.in[IN_XP] + (size_t)r * DM : F.in[IN_XS] + (size_t)(r - NCTX) * DM) + F.lane;
#pragma unroll
            for (int j = 0; j < 4; ++j) x[j] = src[64 * j];
            if (r >= NCTX) { const int t = (r - NCTX) & 2047; const float pr = (float)(t >> 6), pc = (float)(t & 63);
#pragma unroll
                for (int k = 0; k < 4; ++k) { const float q = (float)(4 * F.lane + k); const float om = __builtin_amdgcn_exp2f(q * (-13.287712379549449f / 256.f)) * 0.15915494309189535f;
                    const float ar = pr * om, ac = pc * om;
                    x[0][k] += __builtin_amdgcn_sinf(ar - floorf(ar)); x[1][k] += __builtin_amdgcn_cosf(ar - floorf(ar));
                    x[2][k] += __builtin_amdgcn_sinf(ac - floorf(ac)); x[3][k] += __builtin_amdgcn_cosf(ac - floorf(ac)); } }
        } else {
            const f32x4* sp = (const f32x4*)(SSQ + (size_t)r * 16); const f32x4 s4 = (sp[0] + sp[1]) + (sp[2] + sp[3]);
            const float ry = __builtin_amdgcn_rsqf(((s4[0] + s4[1]) + (s4[2] + s4[3])) * (1.f / 1024.f) + EPS);
            const f32x4* yp = (const f32x4*)(Y + (size_t)r * DM) + F.lane; const f32x4* xp = (const f32x4*)(XR + (size_t)r * DM) + F.lane;
            const f32x4* gp = (const f32x4*)(MOD + (size_t)(l * 5 + cond) * 6144 + (kind == 1 ? 2 : 5) * 1024) + F.lane;
            const f32x4* gq = (const f32x4*)(F.in[kind == 1 ? IN_GQM : IN_GQF] + l * 1024) + F.lane;
#pragma unroll
            for (int j = 0; j < 4; ++j) x[j] = xp[64 * j] + gp[64 * j] * (yp[64 * j] * ry * gq[64 * j]);
        }
        { u32x2* xo = (u32x2*)((bf16_t*)(F.ws + WS_XRB) + (size_t)r * DM) + F.lane;
#pragma unroll
          for (int j = 0; j < 4; ++j) { u32x2 w; w.x = cvt_pk_bf16(x[j][0], x[j][1]); w.y = cvt_pk_bf16(x[j][2], x[j][3]); xo[64 * j] = w; } }
        const int lh = kind == 2 ? l + 1 : l;
        if (lh < DEPTH) {
            float ss = 0.f;
#pragma unroll
            for (int j = 0; j < 4; ++j) ss += (x[j][0] * x[j][0] + x[j][1] * x[j][1]) + (x[j][2] * x[j][2] + x[j][3] * x[j][3]);
            const float rx = __builtin_amdgcn_rsqf(wave_sum(ss) * (1.f / 1024.f) + EPS);
            const float* mb = MOD + (size_t)(lh * 5 + cond) * 6144;
            const f32x4* shp = (const f32x4*)(mb + (kind == 1 ? 3 : 0) * 1024) + F.lane; const f32x4* scp = (const f32x4*)(mb + (kind == 1 ? 4 : 1) * 1024) + F.lane;
            const f32x4* gp = (const f32x4*)(F.in[kind == 1 ? IN_GPF : IN_GPM] + lh * 1024) + F.lane;
            u32x2* ho = (u32x2*)(H + (size_t)r * DM) + F.lane;
#pragma unroll
            for (int j = 0; j < 4; ++j) { const f32x4 hv = x[j] * rx * gp[64 * j] * (scp[64 * j] + 1.0f) + shp[64 * j];
                u32x2 w; w.x = cvt_pk_bf16(hv[0], hv[1]); w.y = cvt_pk_bf16(hv[2], hv[3]); ho[64 * j] = w; }
        }
    }
}

constexpr int GL_ZA = 0, GL_TOT = 8192, GL_RS = 10240, GL_QT = 11264, GL_KT = 29696, GL_VT = 48128, GL_X = 66560, GL_ST = 84992;
__device__ __forceinline__ float logsig(float x) { return fminf(x, 0.f) - __logf(1.f + __expf(-fabsf(x))); }

__device__ __forceinline__ void gla_za_load(const Frame& F, f32x4 (&za)[4], int c) {
    const int fr = F.lane & 15, fq = F.lane >> 4, dir = F.wave & 1;
    const float* g = (const float*)(F.ws + WS_GATES) + (size_t)(c * 64 + fr) * 32 + dir * 16 + fq * 4;
#pragma unroll
    for (int it = 0; it < 4; ++it) za[it] = *(const f32x4*)(g + it * 16 * 32);
}
template <bool MODEC>
__device__ __forceinline__ void gla_item(const Frame& F, f32x4 (&za)[4], const float (&wq)[4], const float bias, int c, int h, int l, bool has_next, int c_next) {
    LAS unsigned char* lds = F.lds;
    LAS float* RS = (LAS float*)(lds + GL_RS);
    const int tid = F.tid, wv = F.wave, fr = F.lane & 15, fq = F.lane >> 4;
    const int dir = wv & 1, d = (wv >> 1) * 16 + fr;
    const int token0 = c * 64;
    const bf16_t* Q = (const bf16_t*)(F.ws + WS_Q); const bf16_t* Kb = (const bf16_t*)(F.ws + WS_K);
    const bf16_t* V = (const bf16_t*)(F.ws + WS_V); bf16_t* KV = (bf16_t*)(F.ws + WS_KV); float* DEC = (float*)(F.ws + WS_DEC);
    unsigned short kraw[16], qraw[MODEC ? 16 : 1], vraw[16];
    {
        const bf16_t* kp = Kb + (size_t)(token0 + fq * 4) * 256 + h * 64 + d;
#pragma unroll
        for (int it = 0; it < 4; ++it)
#pragma unroll
            for (int j = 0; j < 4; ++j) kraw[it * 4 + j] = kp[(it * 16 + j) * 256];
        if (MODEC) { const bf16_t* qp = Q + (size_t)(token0 + fq * 4) * 256 + h * 64 + d;
#pragma unroll
            for (int it = 0; it < 4; ++it)
#pragma unroll
                for (int j = 0; j < 4; ++j) qraw[it * 4 + j] = qp[(it * 16 + j) * 256]; }
        const bf16_t* vp = V + (size_t)(token0 + (tid >> 7) * 16) * 512 + h * 128 + (tid & 127);
#pragma unroll
        for (int jj = 0; jj < 16; ++jj) vraw[jj] = vp[jj * 512];
    }
    u32x4 st4[MODEC ? 4 : 1];
    if (MODEC) { const u32x4* src = (const u32x4*)(KV + (size_t)((c * 4 + h) * 2) * 8192);
#pragma unroll
        for (int e = 0; e < 4; ++e) st4[e] = src[tid + 512 * e]; }
    float b[16];
#pragma unroll
    for (int it = 0; it < 4; ++it) { f32x4 acc = {bias, bias, bias, bias};
#pragma unroll
        for (int ks = 0; ks < 4; ++ks) acc = __builtin_amdgcn_mfma_f32_16x16x4f32(za[it][ks], wq[ks], acc, 0, 0, 0);
#pragma unroll
        for (int j = 0; j < 4; ++j) b[it * 4 + j] = logsig(acc[j]) * 0.0625f; }
    float blast = 0.f;
    if (dir == 0) {
#pragma unroll
        for (int it = 0; it < 4; ++it) {
            b[it * 4 + 1] += b[it * 4]; b[it * 4 + 2] += b[it * 4 + 1]; b[it * 4 + 3] += b[it * 4 + 2];
            const float sgl = b[it * 4 + 3]; float t = sgl;
            float u = __shfl_up(t, 16); if (fq >= 1) t += u;
            u = __shfl_up(t, 32); if (fq >= 2) t += u;
            const float tt = __shfl(t, 48 + fr); const float off = blast + (t - sgl);
#pragma unroll
            for (int j = 0; j < 4; ++j) b[it * 4 + j] += off;
            blast += tt; }
    } else {
#pragma unroll
        for (int it = 3; it >= 0; --it) {
            b[it * 4 + 2] += b[it * 4 + 3]; b[it * 4 + 1] += b[it * 4 + 2]; b[it * 4] += b[it * 4 + 1];
            const float sgl = b[it * 4]; float t = sgl;
            float u = __shfl_down(t, 16); if (fq <= 2) t += u;
            u = __shfl_down(t, 32); if (fq <= 1) t += u;
            const float tt = __shfl(t, fr); const float off = blast + (t - sgl);
#pragma unroll
            for (int j = 0; j < 4; ++j) b[it * 4 + j] += off;
            blast += tt; }
    }
    {
        const int dv = tid & 127, jg = tid >> 7; unsigned pk[8];
#pragma unroll
        for (int jj = 0; jj < 16; jj += 2) pk[jj >> 1] = (unsigned)vraw[jj] | ((unsigned)vraw[jj + 1] << 16);
        LAS u32x4* dst = (LAS u32x4*)(lds + GL_VT + (dv * 72 + jg * 16) * 2);
        dst[0] = (u32x4){pk[0], pk[1], pk[2], pk[3]}; dst[1] = (u32x4){pk[4], pk[5], pk[6], pk[7]};
        if (MODEC) {
#pragma unroll
            for (int e = 0; e < 4; ++e) { const int ch = tid + 512 * e; const int ds = ch >> 10, dvv = (ch >> 3) & 127, d8 = ch & 7;
                *(LAS u32x4*)(lds + GL_ST + ((ds * 128 + dvv) * 72 + d8 * 8) * 2) = st4[e]; }
        }
    }
    if (MODEC) {
        LAS bf16_t* QT = (LAS bf16_t*)(lds + GL_QT); LAS bf16_t* KT = (LAS bf16_t*)(lds + GL_KT);
#pragma unroll
        for (int it = 0; it < 4; ++it)
#pragma unroll
            for (int j = 0; j < 4; ++j) { const int i = it * 16 + fq * 4 + j; const float bb_ = b[it * 4 + j];
                const unsigned pk = cvt_pk_bf16(bf2f(qraw[it * 4 + j]) * __expf(bb_), bf2f(kraw[it * 4 + j]) * __expf(-bb_));
                QT[(dir * 64 + i) * 72 + d] = (bf16_t)(pk & 0xffffu); KT[(dir * 64 + i) * 72 + d] = (bf16_t)(pk >> 16); }
    } else {
#pragma unroll
        for (int it = 0; it < 4; ++it) { u32x2 o;
            o.x = cvt_pk_bf16(bf2f(kraw[it * 4 + 0]) * __expf(blast - b[it * 4 + 0]), bf2f(kraw[it * 4 + 1]) * __expf(blast - b[it * 4 + 1]));
            o.y = cvt_pk_bf16(bf2f(kraw[it * 4 + 2]) * __expf(blast - b[it * 4 + 2]), bf2f(kraw[it * 4 + 3]) * __expf(blast - b[it * 4 + 3]));
            *(LAS u32x2*)(lds + GL_X + ((dir * 64 + d) * 72 + it * 16 + fq * 4) * 2) = o; }
        if (fq == 0) DEC[(size_t)((c * 4 + h) * 2 + dir) * 64 + d] = __expf(blast);
    }
    __syncthreads();
    if (has_next) gla_za_load(F, za, c_next);
    if (!MODEC) {
        const int dw = wv & 1, dvp = wv >> 1;
        bf16x8 a[4][2], bb[2][2];
#pragma unroll
        for (int td = 0; td < 4; ++td)
#pragma unroll
            for (int kk = 0; kk < 2; ++kk) a[td][kk] = *(const LAS bf16x8*)(lds + GL_X + ((dw * 64 + td * 16 + fr) * 72 + kk * 32 + fq * 8) * 2);
#pragma unroll
        for (int tv = 0; tv < 2; ++tv)
#pragma unroll
            for (int kk = 0; kk < 2; ++kk) bb[tv][kk] = *(const LAS bf16x8*)(lds + GL_VT + ((dvp * 32 + tv * 16 + fr) * 72 + kk * 32 + fq * 8) * 2);
        bf16_t* kvo = KV + (size_t)((c * 4 + h) * 2 + dw) * 8192;
#pragma unroll
        for (int td = 0; td < 4; ++td)
#pragma unroll
            for (int tv = 0; tv < 2; ++tv) { f32x4 acc = {0.f, 0.f, 0.f, 0.f};
#pragma unroll
                for (int kk = 0; kk < 2; ++kk) acc = __builtin_amdgcn_mfma_f32_16x16x32_bf16(a[td][kk], bb[tv][kk], acc, 0, 0, 0);
                u32x2 o; o.x = cvt_pk_bf16(acc[0], acc[1]); o.y = cvt_pk_bf16(acc[2], acc[3]);
                *(u32x2*)(kvo + (size_t)(dvp * 32 + tv * 16 + fr) * 64 + td * 16 + fq * 4) = o; }
        __syncthreads();
    } else {
        {
            const int dw = wv & 1, ti = wv >> 1;
            bf16x8 bq[2];
#pragma unroll
            for (int kk = 0; kk < 2; ++kk) bq[kk] = *(const LAS bf16x8*)(lds + GL_QT + ((dw * 64 + ti * 16 + fr) * 72 + kk * 32 + fq * 8) * 2);
            const int i = ti * 16 + fr;
#pragma unroll
            for (int tj = 0; tj < 4; ++tj) { f32x4 acc = {0.f, 0.f, 0.f, 0.f};
#pragma unroll
                for (int kk = 0; kk < 2; ++kk) { const bf16x8 ak = *(const LAS bf16x8*)(lds + GL_KT + ((dw * 64 + tj * 16 + fr) * 72 + kk * 32 + fq * 8) * 2);
                    acc = __builtin_amdgcn_mfma_f32_16x16x32_bf16(ak, bq[kk], acc, 0, 0, 0); }
#pragma unroll
                for (int jj = 0; jj < 4; ++jj) { const int j = tj * 16 + fq * 4 + jj; const bool keep = dw == 0 ? (j <= i) : (j >= i); if (!keep) acc[jj] = 0.f; }
                u32x2 o; o.x = cvt_pk_bf16(acc[0], acc[1]); o.y = cvt_pk_bf16(acc[2], acc[3]);
                *(LAS u32x2*)(lds + GL_X + ((dw * 64 + i) * 72 + tj * 16 + fq * 4) * 2) = o; }
        }
        const int ti = wv & 3, dvh = wv >> 2, i = ti * 16 + fr;
        const bf16_t* SG = (const bf16_t*)(F.ws + WS_SG); bf16_t* A2 = (bf16_t*)(F.ws + WS_A2);
        u32x4 sgv[2]; f32x4 gv[4];
#pragma unroll
        for (int p = 0; p < 2; ++p) { const int dv0 = dvh * 64 + p * 32 + 8 * fq;
            gv[2 * p] = *(const f32x4*)(F.in[IN_GGLA] + l * 128 + dv0); gv[2 * p + 1] = *(const f32x4*)(F.in[IN_GGLA] + l * 128 + dv0 + 4);
            sgv[p] = *(const u32x4*)(SG + (size_t)(token0 + i) * 512 + h * 128 + dv0); }
        __syncthreads();
        f32x4 o[4];
        {
            bf16x8 batt[2][2], bqt[2][2];
#pragma unroll
            for (int ds = 0; ds < 2; ++ds)
#pragma unroll
                for (int kk = 0; kk < 2; ++kk) { batt[ds][kk] = *(const LAS bf16x8*)(lds + GL_X + ((ds * 64 + i) * 72 + kk * 32 + fq * 8) * 2);
                    bqt[ds][kk] = *(const LAS bf16x8*)(lds + GL_QT + ((ds * 64 + i) * 72 + kk * 32 + fq * 8) * 2); }
#pragma unroll
            for (int t = 0; t < 4; ++t) { const int vrow = dvh * 64 + (t >> 1) * 32 + 8 * (fr >> 2) + 4 * (t & 1) + (fr & 3); f32x4 acc = {0.f, 0.f, 0.f, 0.f};
#pragma unroll
                for (int kk = 0; kk < 2; ++kk) { const bf16x8 av = *(const LAS bf16x8*)(lds + GL_VT + (vrow * 72 + kk * 32 + fq * 8) * 2);
#pragma unroll
                    for (int ds = 0; ds < 2; ++ds) { acc = __builtin_amdgcn_mfma_f32_16x16x32_bf16(av, batt[ds][kk], acc, 0, 0, 0);
                        const bf16x8 as = *(const LAS bf16x8*)(lds + GL_ST + ((ds * 128 + vrow) * 72 + kk * 32 + fq * 8) * 2);
                        acc = __builtin_amdgcn_mfma_f32_16x16x32_bf16(as, bqt[ds][kk], acc, 0, 0, 0); } }
                o[t] = acc; }
        }
        float ss = 0.f;
#pragma unroll
        for (int t = 0; t < 4; ++t) ss += (o[t][0] * o[t][0] + o[t][1] * o[t][1]) + (o[t][2] * o[t][2] + o[t][3] * o[t][3]);
        ss += __shfl_xor(ss, 16); ss += __shfl_xor(ss, 32);
        if (fq == 0) RS[dvh * 64 + i] = ss;
        __syncthreads();
        const float rn = __builtin_amdgcn_rsqf((RS[i] + RS[64 + i]) * (1.f / 128.f) + EPS);
#pragma unroll
        for (int p = 0; p < 2; ++p) { const int dv0 = dvh * 64 + p * 32 + 8 * fq;
            const f32x4 v0 = o[2 * p] * rn * gv[2 * p], v1 = o[2 * p + 1] * rn * gv[2 * p + 1]; const u32x4 sg = sgv[p];
            u32x4 wo; wo.x = cvt_pk_bf16(v0[0] * silu_f(bf2f(sg.x & 0xffffu)), v0[1] * silu_f(bf2f(sg.x >> 16))); wo.y = cvt_pk_bf16(v0[2] * silu_f(bf2f(sg.y & 0xffffu)), v0[3] * silu_f(bf2f(sg.y >> 16)));
            wo.z = cvt_pk_bf16(v1[0] * silu_f(bf2f(sg.z & 0xffffu)), v1[1] * silu_f(bf2f(sg.z >> 16))); wo.w = cvt_pk_bf16(v1[2] * silu_f(bf2f(sg.w & 0xffffu)), v1[3] * silu_f(bf2f(sg.w >> 16)));
            *(u32x4*)(A2 + (size_t)(token0 + i) * KOUT + 1024 + h * 128 + dv0) = wo; }
        __syncthreads();
    }
}

__device__ __forceinline__ void scan_phase(const Frame& F, int l) {
    bf16_t* KV = (bf16_t*)(F.ws + WS_KV); const float* DEC = (const float*)(F.ws + WS_DEC);
    float* ostate = F.out + (size_t)MTOK * DM;
    const int half = F.tid >> 8, t = F.tid & 255;
    if (half == 0) {
        for (int it = F.bid; it < 256; it += F.G) {
            const int chain = it >> 3, eb = it & 7, dir = chain & 1, h = (chain >> 1) & 3, bq = chain >> 3, c0 = 128 + 32 * bq;
            const int e = eb * 1024 + t * 4, dv = e >> 6, dk = e & 63;
            const float* sp = F.in[IN_STATE] + ((size_t)(((bq * 2 + l) * 2 + dir) * 4 + h) * 64 + dk) * 128 + dv;
            f32x4 sv = {sp[0], sp[128], sp[256], sp[384]};
            for (int n0 = 0; n0 < 32; n0 += 16) {
                u32x2 kv[16]; f32x4 dc[16];
#pragma unroll
                for (int u = 0; u < 16; ++u) { const int n = dir == 0 ? n0 + u : 31 - (n0 + u); const size_t idx = (size_t)((c0 + n) * 4 + h) * 2 + dir;
                    kv[u] = *(const u32x2*)(KV + idx * 8192 + e); dc[u] = *(const f32x4*)(DEC + idx * 64 + dk); }
#pragma unroll
                for (int u = 0; u < 16; ++u) { const int n = dir == 0 ? n0 + u : 31 - (n0 + u); const size_t idx = (size_t)((c0 + n) * 4 + h) * 2 + dir;
                    u32x2 o; o.x = cvt_pk_bf16(sv[0], sv[1]); o.y = cvt_pk_bf16(sv[2], sv[3]); *(u32x2*)(KV + idx * 8192 + e) = o;
                    const f32x4 kf = {bf2f(kv[u].x & 0xffffu), bf2f(kv[u].x >> 16), bf2f(kv[u].y & 0xffffu), bf2f(kv[u].y >> 16)};
                    sv = dc[u] * sv + kf; }
            }
        }
    } else {
        for (int p0 = F.bid; p0 < 1024; p0 += 2 * F.G) {
            u32x4 kv[2][4]; f32x4 dc[2][4][2];
#pragma unroll
            for (int q = 0; q < 2; ++q) { const int p = p0 + q * F.G; if (p < 1024) { const int chain = p >> 2, qt = p & 3, dir = chain & 1, h = (chain >> 1) & 3, bq = chain >> 3;
                const int e = qt * 2048 + t * 8, dk = e & 63;
#pragma unroll
                for (int u = 0; u < 4; ++u) { const int n = dir == 0 ? u : 3 - u; const size_t idx = (size_t)((4 * bq + n) * 4 + h) * 2 + dir;
                    kv[q][u] = *(const u32x4*)(KV + idx * 8192 + e); dc[q][u][0] = *(const f32x4*)(DEC + idx * 64 + dk); dc[q][u][1] = *(const f32x4*)(DEC + idx * 64 + dk + 4); } } }
#pragma unroll
            for (int q = 0; q < 2; ++q) { const int p = p0 + q * F.G; if (p < 1024) { const int chain = p >> 2, qt = p & 3, dir = chain & 1, h = (chain >> 1) & 3, bq = chain >> 3;
                const int e = qt * 2048 + t * 8, dv = e >> 6, dk = e & 63;
                float z0_ = 0.f; asm volatile("" : "+v"(z0_));
                f32x4 s0 = {z0_, z0_, z0_, z0_}, s1 = s0;
#pragma unroll
                for (int u = 0; u < 4; ++u) { const int n = dir == 0 ? u : 3 - u; const size_t idx = (size_t)((4 * bq + n) * 4 + h) * 2 + dir;
                    u32x4 o; o.x = cvt_pk_bf16(s0[0], s0[1]); o.y = cvt_pk_bf16(s0[2], s0[3]); o.z = cvt_pk_bf16(s1[0], s1[1]); o.w = cvt_pk_bf16(s1[2], s1[3]);
                    *(u32x4*)(KV + idx * 8192 + e) = o;
                    const u32x4 k4 = kv[q][u];
                    const f32x4 k0 = {bf2f(k4.x & 0xffffu), bf2f(k4.x >> 16), bf2f(k4.y & 0xffffu), bf2f(k4.y >> 16)}, k1 = {bf2f(k4.z & 0xffffu), bf2f(k4.z >> 16), bf2f(k4.w & 0xffffu), bf2f(k4.w >> 16)};
                    s0 = dc[q][u][0] * s0 + k0; s1 = dc[q][u][1] * s1 + k1; }
                float* op = ostate + ((size_t)(((bq * 2 + l) * 2 + dir) * 4 + h) * 64 + dk) * 128 + dv;
                op[0] = s0[0]; op[128] = s0[1]; op[256] = s0[2]; op[384] = s0[3]; op[512] = s1[0]; op[640] = s1[1]; op[768] = s1[2]; op[896] = s1[3]; } }
        }
    }
}


#define XB_TMO      128
#define XB_XCNT(j)  (256  + 64 * (j))
#define XB_XSUB(j)  (1280 + 64 * (j))
#define XB_XGEN(j)  (2304 + 64 * (j))
#define XB_TOP      3328
#define XB_TOPGEN   3392
#define XCD_BAR_WORDS 3456
#define XB_SPIN_CAP (1u << 22)
__device__ __forceinline__ unsigned xb_ld(unsigned* p)              { return __hip_atomic_load(p, __ATOMIC_RELAXED, __HIP_MEMORY_SCOPE_AGENT); }
__device__ __forceinline__ unsigned xb_add(unsigned* p, unsigned v) { return __hip_atomic_fetch_add(p, v, __ATOMIC_RELAXED, __HIP_MEMORY_SCOPE_AGENT); }
__device__ __forceinline__ unsigned xb_xcc_id() { return (unsigned)__builtin_amdgcn_s_getreg((3 << 11) | 20) & 0xFu; }
#define XB_SPIN(cond, bar) do { unsigned _sp = 0; while (cond) { __builtin_amdgcn_s_sleep(1); \
    if ((++_sp & 255u) == 0u) { if (xb_ld(&(bar)[XB_TMO])) break; if (_sp > XB_SPIN_CAP) { atomicAdd(&(bar)[XB_TMO], 1u); break; } } } } while (0)
struct XcdBarrier { unsigned* bar; unsigned x; volatile LAS unsigned* st; };
__device__ __forceinline__ XcdBarrier xcd_barrier_post(unsigned* bar, volatile LAS unsigned* st) {
    XcdBarrier b; b.bar = bar; b.x = xb_xcc_id(); b.st = st;
    if (threadIdx.x == 0) (void)xb_add(&bar[XB_XCNT(b.x)], 1u);
    return b;
}
__device__ __forceinline__ void xcd_barrier_complete(unsigned* bar, unsigned x, unsigned& nloc, unsigned& nx) {
    const unsigned G = gridDim.x * gridDim.y * gridDim.z;
    unsigned sum, cnt, mine, sp = 0u;
    for (;;) {
        sum = 0u; cnt = 0u; mine = 0u;
#pragma unroll
        for (unsigned j = 0; j < 16; ++j) { const unsigned c = xb_ld(&bar[XB_XCNT(j)]); sum += c; cnt += (c > 0u) ? 1u : 0u; mine = (j == x) ? c : mine; }
        if (sum == G) break;
        __builtin_amdgcn_s_sleep(1);
        if ((++sp & 255u) == 0u) { if (xb_ld(&bar[XB_TMO])) break; if (sp > XB_SPIN_CAP) { atomicAdd(&bar[XB_TMO], 1u); break; } }
    }
    nloc = mine > 0u ? mine : 1u; nx = cnt > 0u ? cnt : 1u;
}
__device__ __forceinline__ void xcd_barrier(const XcdBarrier& b) {
    asm volatile("s_waitcnt vmcnt(0)" ::: "memory");
    __syncthreads();
    if (threadIdx.x == 0) {
        unsigned* bar = b.bar;
        __builtin_amdgcn_s_waitcnt(0);
        unsigned nloc = b.st[0], nx = b.st[1];
        if (nloc == 0u) { xcd_barrier_complete(bar, b.x, nloc, nx); b.st[0] = nloc; b.st[1] = nx; }
        const unsigned old = xb_add(&bar[XB_XSUB(b.x)], 1u);
        const unsigned gen = old / nloc;
        if (old + 1u == (gen + 1u) * nloc) {
            __builtin_amdgcn_fence(__ATOMIC_RELEASE, "agent");
            asm volatile("s_waitcnt vmcnt(0)" ::: "memory");
            const unsigned og = xb_add(&bar[XB_TOP], 1u);
            const unsigned tg = og / nx;
            if (og + 1u == (tg + 1u) * nx) xb_add(&bar[XB_TOPGEN], 1u);
            else XB_SPIN(xb_ld(&bar[XB_TOPGEN]) == tg, bar);
            __builtin_amdgcn_fence(__ATOMIC_ACQUIRE, "agent");
            xb_add(&bar[XB_XGEN(b.x)], 1u);
            asm volatile("s_waitcnt vmcnt(0)" ::: "memory");
        } else {
            XB_SPIN(xb_ld(&bar[XB_XGEN(b.x)]) == gen, bar);
            __builtin_amdgcn_fence(__ATOMIC_ACQUIRE, "agent");
            asm volatile("s_waitcnt vmcnt(0)" ::: "memory");
        }
    }
    __syncthreads();
}

__global__ void __launch_bounds__(512, 2) mk_fwd(Args args) {
    extern __shared__ __attribute__((aligned(16))) unsigned char lds_raw[];
    cg::grid_group grid = cg::this_grid();
    Frame F0; {Frame& F = F0;
    F.lds = (LAS unsigned char*)lds_raw; F.tid = threadIdx.x; F.lane = F.tid & 63; F.wave = __builtin_amdgcn_readfirstlane(F.tid >> 6);
    F.G = gridDim.x; F.bid = blockIdx.x; F.in = args.in; F.out = args.out; F.ws = args.ws; }
#define OPAQ_S(x) asm volatile("" : "+s"(x))
#define PHASE_FRAME(lv) Frame F = F0; { int w_ = F0.wave; OPAQ_S(w_); int ln_; asm volatile("v_mbcnt_lo_u32_b32 %0, -1, 0\n\tv_mbcnt_hi_u32_b32 %0, -1, %0" : "=v"(ln_)); F.tid = w_ * 64 + ln_; } asm volatile("" : "+v"(F.tid)); F.lane = F.tid & 63; F.wave = __builtin_amdgcn_readfirstlane(F.tid >> 6); { size_t z_ = 0; OPAQ_S(z_); F.ws = args.ws + z_; F.out = args.out + z_; } OPAQ_S(F.G); OPAQ_S(F.bid); int l = (lv); OPAQ_S(l); unsigned char* ws = F.ws; (void)ws; (void)l;
#ifndef PHM
#define PHM 0xFFFF
#endif
    unsigned* barw = (unsigned*)(args.ws + WS_BAR);
    volatile LAS unsigned* bst = (volatile LAS unsigned*)((LAS unsigned char*)lds_raw + MISC_OFF);
    if (threadIdx.x < 2) bst[threadIdx.x] = 0u;
    __syncthreads();
    XcdBarrier xbar = xcd_barrier_post(barw, bst);
    if (args.ph_hi < 0) grid.sync();
    int ph = 0;
#define RUN(k) ((k) >= args.ph_lo && (k) < args.ph_hi)
#define SEAM() do { if (ph + 1 < args.ph_hi && ph >= args.ph_lo) { XcdBarrier xb_ = xbar; size_t z_ = 0; OPAQ_S(z_); xb_.bar = barw + z_; xcd_barrier(xb_); } ++ph; } while (0)
    if (RUN(ph) && (PHM & 1)) { PHASE_FRAME(0) prep_gemv(F); }
    SEAM();
    if (RUN(ph) && (PHM & 2)) { PHASE_FRAME(0) prep_rest(F); }
    SEAM();
    for (int l0 = 0; l0 < DEPTH; ++l0) {
        if (RUN(ph) && (PHM & 4)) { PHASE_FRAME(l0)
            pg8::TileOrder S; S.init(ws + WS_H, ws + WS_WIN + (size_t)l * N1 * 1024 * 2, MTOK, 2048, 1024, 1024, F.G, F.bid);
            EpiIn E{(bf16_t*)(ws + WS_ZT), (bf16_t*)(ws + WS_Q), (bf16_t*)(ws + WS_K), (bf16_t*)(ws + WS_V), (bf16_t*)(ws + WS_SG), (float*)(ws + WS_GATES)};
            pg8::gemm_phase<EpiIn, pg8::TileOrder, true, 1024, 1024>(F.lds, F.tid, S, E);
            for (int rt = F.bid; rt < MTOK / 64; rt += F.G) gate_rows(F.lds, F.tid, rt * 64, (const bf16_t*)(ws + WS_H), (const bf16_t*)(ws + WS_WIN) + ((size_t)l * N1 + 2048) * 1024, (float*)(ws + WS_GATES));
        }
        SEAM();
        if (RUN(ph) && (PHM & 8)) { PHASE_FRAME(l0)
            const int Gh = F.G >> 1; EpiStore E{};
            const bool smp = F.bid < Gh;
            DftOrder S{(const char*)(ws + (smp ? WS_DS : WS_DC)), (const char*)(ws + WS_ZT + (smp ? 8 * MiB : 0)), (char*)(ws + WS_A2), smp ? Gh : F.G - Gh, smp ? F.bid : F.bid - Gh, smp};
            if (smp) pg8::gemm_phase<EpiStore, DftOrder, true, 2048, 2048>(F.lds, F.tid, S, E);
            else pg8::gemm_phase<EpiStore, DftOrder, true, 256, 256>(F.lds, F.tid, S, E);
            __syncthreads();
            if (!smp) {
                const int nb = F.G - Gh, b0 = F.bid - Gh, lo = 0, hi = 1024;
                const int h_ = (lo + b0) & 3; float wq_[4]; float bias_; f32x4 za_[4];
                { const int d_ = (F.wave >> 1) * 16 + (F.lane & 15), dir_ = F.wave & 1, fq_ = F.lane >> 4; const float* wg = F.in[dir_ ? IN_WGB : IN_WGF] + l * 16 * 256 + h_ * 64 + d_;
#pragma unroll
                  for (int ks = 0; ks < 4; ++ks) wq_[ks] = wg[(fq_ * 4 + ks) * 256];
                  bias_ = F.in[dir_ ? IN_BGB : IN_BGF][l * 256 + h_ * 64 + d_]; }
                int it = lo + b0; gla_za_load(F, za_, (it < hi ? it : hi - 1) >> 2);
                for (; it < hi; it += nb) gla_item<false>(F, za_, wq_, bias_, it >> 2, h_, l, it + nb < hi, (it + nb) >> 2);
            }
        }
        SEAM();
        if (RUN(ph) && (PHM & 16)) { PHASE_FRAME(l0) scan_phase(F, l); }
        SEAM();
        if (RUN(ph) && (PHM & 32)) { PHASE_FRAME(l0) const int h_ = F.bid & 3; float wq_[4]; float bias_; f32x4 za_[4];
            { const int d_ = (F.wave >> 1) * 16 + (F.lane & 15), dir_ = F.wave & 1, fq_ = F.lane >> 4; const float* wg = F.in[dir_ ? IN_WGB : IN_WGF] + l * 16 * 256 + h_ * 64 + d_;
#pragma unroll
              for (int ks = 0; ks < 4; ++ks) wq_[ks] = wg[(fq_ * 4 + ks) * 256];
              bias_ = F.in[dir_ ? IN_BGB : IN_BGF][l * 256 + h_ * 64 + d_]; }
            int it = F.bid; gla_za_load(F, za_, (it < 1024 ? it : 1023) >> 2);
            for (; it < 1024; it += F.G) gla_item<true>(F, za_, wq_, bias_, it >> 2, h_, l, it + F.G < 1024, (it + F.G) >> 2); }
        SEAM();
        if (RUN(ph) && (PHM & 64)) { PHASE_FRAME(l0)
            pg8::TileOrder S; S.init(ws + WS_A2, ws + WS_WOUT + (size_t)l * 1024 * KOUT * 2, MTOK, 1024, KOUT, KOUT, F.G, F.bid);
            EpiRows E{nullptr, (bf16_t*)(ws + WS_XRB), (bf16_t*)(ws + WS_H), (const float*)(ws + WS_MOD), F.in[IN_GQM] + l * 1024, F.in[IN_GPF] + l * 1024, l, 2, l, 4, 3, true,
                      (unsigned*)(ws + WS_XBUF) + (size_t)(l * 2 + 0) * 2 * 64 * 1024, (unsigned*)(ws + WS_XCNT) + (size_t)(l * 2 + 0) * 2 * 64 * 64};
            pg8::gemm_phase<EpiRows, pg8::TileOrder, true, KOUT, KOUT>(F.lds, F.tid, S, E);
        }
        SEAM();
        if (RUN(ph) && (PHM & 256)) { PHASE_FRAME(l0)
            pg8::TileOrder S; S.init(ws + WS_H, ws + WS_WUP + (size_t)l * NUP * 1024 * 2, MTOK, NUP, 1024, 1024, F.G, F.bid);
            EpiConv E{(bf16_t*)(ws + WS_ACT), F.in[IN_CW] + (size_t)l * 3 * NUP, F.in[IN_CB] + (size_t)l * NUP};
            pg8::gemm_phase<EpiConv, pg8::TileOrder, true, 1024, 1024>(F.lds, F.tid, S, E);
        }
        SEAM();
        if (RUN(ph) && (PHM & 512)) { PHASE_FRAME(l0)
            pg8::TileOrder S; S.init(ws + WS_ACT, ws + WS_WDN + (size_t)l * 1024 * DFF * 2, MTOK, 1024, DFF, DFF, F.G, F.bid);
            const int ln = l + 1 < DEPTH ? l + 1 : l;
            EpiRows E{l + 1 < DEPTH ? nullptr : F.out, (bf16_t*)(ws + WS_XRB), (bf16_t*)(ws + WS_H), (const float*)(ws + WS_MOD), F.in[IN_GQF] + l * 1024, F.in[IN_GPM] + ln * 1024, l, 5, ln, 1, 0, l + 1 < DEPTH,
                      (unsigned*)(ws + WS_XBUF) + (size_t)(l * 2 + 1) * 2 * 64 * 1024, (unsigned*)(ws + WS_XCNT) + (size_t)(l * 2 + 1) * 2 * 64 * 64};
            pg8::gemm_phase<EpiRows, pg8::TileOrder, true, DFF, DFF>(F.lds, F.tid, S, E);
        }
        SEAM();
    }
#undef RUN
#undef SEAM
}
constexpr int N_PHASES = 2 + 7 * DEPTH;
__global__ void dbg_copy(const unsigned short* src, float* out, size_t n) { for (size_t i = blockIdx.x * (size_t)blockDim.x + threadIdx.x; i < n; i += (size_t)gridDim.x * blockDim.x) out[i] = __uint_as_float((unsigned)src[i] << 16); }
__global__ void dbg_copyf(const float* src, float* out, size_t n) { for (size_t i = blockIdx.x * (size_t)blockDim.x + threadIdx.x; i < n; i += (size_t)gridDim.x * blockDim.x) out[i] = src[i]; }

#ifndef MK_LAST
#define MK_LAST (N_PHASES - 1)
#endif
#ifndef MK_MULTI
#define MK_MULTI 0
#endif
extern "C" void kernel_launch(void* const* d_in, const int* in_sizes, int n_in, void* d_out, int out_size, void* d_ws, size_t ws_size, hipStream_t stream) {
    static int grid = 0;
    if (grid == 0) {
        if (n_in != 22 || ws_size < WS_END) { fprintf(stderr, "kernel_launch: unexpected inputs (n_in %d, ws %zu)\n", n_in, ws_size); grid = -1; return; }
        int dev = 0, cus = 0, per_cu = 0;
        hipGetDevice(&dev); hipDeviceGetAttribute(&cus, hipDeviceAttributeMultiprocessorCount, dev);
        hipFuncSetAttribute((const void*)mk_fwd, hipFuncAttributeMaxDynamicSharedMemorySize, LDS_BYTES);
        if (hipOccupancyMaxActiveBlocksPerMultiprocessor(&per_cu, (const void*)mk_fwd, 512, LDS_BYTES) != hipSuccess || per_cu < 1) { fprintf(stderr, "kernel_launch: occupancy query says %d blocks/CU\n", per_cu); per_cu = 1; }
        (void)hipGetLastError();
        grid = cus;
        if (grid & 1) grid -= 1;
    }
    if (grid < 0) return;
    if (hipMemsetAsync((char*)d_ws + WS_BAR, 0, 256 * 1024, stream) != hipSuccess) fprintf(stderr, "memset of barrier words failed\n");
    Args a{};
    for (int i = 0; i < 22; ++i) a.in[i] = (const float*)d_in[i];
    a.out = (float*)d_out; a.ws = (unsigned char*)d_ws;
#if MK_MULTI
    for (int p = 0; p < MK_LAST + 1; ++p) { a.ph_lo = p; a.ph_hi = p + 1; hipLaunchKernelGGL(mk_fwd, dim3(grid), dim3(512), LDS_BYTES, stream, a); }
#ifdef MK_DBG
    MK_DBG
#endif
#else
    a.ph_lo = 0; a.ph_hi = N_PHASES;
    void* kargs[] = {&a};
    hipError_t e = hipLaunchCooperativeKernel((const void*)mk_fwd, dim3(grid), dim3(512), kargs, LDS_BYTES, stream);
    if (e != hipSuccess) fprintf(stderr, "cooperative launch failed: %s (grid %d)\n", hipGetErrorString(e), grid);
#endif
}
```

```cpp
#include <hip/hip_runtime.h>
#include <hip/hip_cooperative_groups.h>
#include <cstdio>
#include <cstdint>
namespace cg = cooperative_groups;

#define LAS __attribute__((address_space(3)))
typedef unsigned short bf16_t;
typedef short bf16x8 __attribute__((ext_vector_type(8)));
typedef float f32x4 __attribute__((ext_vector_type(4)));
typedef unsigned u32x4 __attribute__((ext_vector_type(4)));
typedef unsigned u32x2 __attribute__((ext_vector_type(2)));

constexpr int DM = 1024, MTOK = 16384, NCTX = 8192, DEPTH = 2;
constexpr int N1 = 2304;
constexpr int KOUT = 1536;
constexpr int DFF = 2816, NUP = 5632;
constexpr float EPS = 1e-6f;
constexpr size_t MiB = 1u << 20;
constexpr size_t WS_MOD = 0;
constexpr size_t MOD_BYTES = 2 * 5 * 6144 * 4;
constexpr size_t WS_BAR = 1 * MiB;
constexpr size_t WS_XCNT = 1 * MiB + 64 * 1024;
constexpr size_t WS_XBUF = 250 * MiB;
constexpr size_t WS_SSQ = 2 * MiB;
constexpr size_t WS_DEC = 3 * MiB;
constexpr size_t WS_WIN = 4 * MiB;
constexpr size_t WS_WOUT = 13 * MiB;
constexpr size_t WS_WUP = 19 * MiB;
constexpr size_t WS_WDN = 41 * MiB;
constexpr size_t WS_DS = 52 * MiB;
constexpr size_t WS_DC = 68 * MiB;
constexpr size_t WS_H = 70 * MiB;
constexpr size_t WS_ZT = 102 * MiB;
constexpr size_t WS_Q = 118 * MiB;
constexpr size_t WS_K = 126 * MiB;
constexpr size_t WS_V = 134 * MiB;
constexpr size_t WS_SG = 150 * MiB;
constexpr size_t WS_GATES = 166 * MiB;
constexpr size_t WS_A2 = 168 * MiB;
constexpr size_t WS_KV = 70 * MiB;
constexpr size_t WS_XRB = 216 * MiB;
constexpr size_t WS_Y1 = 102 * MiB;
constexpr size_t WS_ACT = 102 * MiB;
constexpr size_t WS_Y2 = 190 * MiB;
constexpr size_t WS_END = 254 * MiB;
constexpr int LDS_BYTES = 147456;
constexpr int MISC_OFF = 139264;
constexpr int XCH_OFF = 131072;

typedef __bf16 bf16x2_t __attribute__((ext_vector_type(2)));
typedef float f32x2_t __attribute__((ext_vector_type(2)));
__device__ __forceinline__ unsigned cvt_pk_bf16(float lo, float hi) { const f32x2_t v = {lo, hi}; const bf16x2_t b = __builtin_convertvector(v, bf16x2_t); return __builtin_bit_cast(unsigned, b); }
__device__ __forceinline__ float bf2f(unsigned h) { return __uint_as_float(h << 16); }
__device__ __forceinline__ float wave_sum(float v) {
#pragma unroll
    for (int o = 1; o < 64; o <<= 1) v += __shfl_xor(v, o);
    return v;
}
__device__ __forceinline__ float dpp_ror1(float v) { return __int_as_float(__builtin_amdgcn_update_dpp(__float_as_int(v), __float_as_int(v), 0x121, 0xf, 0xf, false)); }
__device__ __forceinline__ float dpp_rol1(float v) { return __int_as_float(__builtin_amdgcn_update_dpp(__float_as_int(v), __float_as_int(v), 0x12F, 0xf, 0xf, false)); }
__device__ __forceinline__ float dpp_swap1(float v) { return __int_as_float(__builtin_amdgcn_update_dpp(__float_as_int(v), __float_as_int(v), 0xB1, 0xf, 0xf, false)); }
__device__ __forceinline__ float silu_f(float x) { return x * __builtin_amdgcn_rcpf(1.0f + __expf(-x)); }

namespace pg8 {
constexpr int BM = 256, BK = 64, HALF = 128, HTB = HALF * BK * 2, NXCD = 8, WGM = 8;
__device__ __forceinline__ int lds_byte(int r, int c) { const int st = (r >> 4) * 2 + (c >> 5), rr = r & 15, cc = c & 31, ob = rr * 64 + cc * 2; return st * 1024 + (ob ^ (((ob >> 9) & 1) << 5)); }
__device__ __forceinline__ void stage_rc(int b, int& R, int& C) { const int st = b / 1024, sb = b % 1024, swz = sb ^ (((sb >> 9) & 1) << 5); R = (st >> 1) * 16 + swz / 64; C = (st & 1) * 32 + (swz % 64) / 2; }

struct Unit { const char* a; const char* b; char* o; int pm, pn; };
__device__ __forceinline__ const char* uni_ptr(const char* p) { const unsigned long long v = (unsigned long long)p; const unsigned lo = __builtin_amdgcn_readfirstlane((unsigned)v), hi = __builtin_amdgcn_readfirstlane((unsigned)(v >> 32)); return (const char*)(((unsigned long long)hi << 32) | lo); }

struct TileOrder {
    const char* A; const char* B; size_t a_tile, b_tile; int nM, nN, nwg, G, c;
    __device__ void init(const void* A_, const void* B_, int M, int N, int lda, int ldb, int G_, int c_) { A = (const char*)A_; B = (const char*)B_; a_tile = (size_t)256 * lda * 2; b_tile = (size_t)256 * ldb * 2; nM = M / BM; nN = N / BM; nwg = nM * nN; G = G_; c = c_; }
    __device__ bool next(int i, Unit& u) const {
        const long L = (long)i * G + c; if (L >= nwg) return false;
        int wgid = (int)L; { const int q = nwg / NXCD, r = nwg % NXCD, xcd = wgid % NXCD, off = wgid / NXCD; wgid = (xcd < r ? xcd * (q + 1) : r * (q + 1) + (xcd - r) * q) + off; }
        const int nig = WGM * nN, gid = wgid / nig, fm = gid * WGM, gsz = (nM - fm) < WGM ? (nM - fm) : WGM;
        u.pm = fm + ((wgid % nig) % gsz); u.pn = (wgid % nig) / gsz; u.a = A + (size_t)u.pm * a_tile; u.b = B + (size_t)u.pn * b_tile; u.o = nullptr; return true;
    }
};

template <class Epi, class Sched, bool ALIGN_EPI, int K, int LD>
__device__ __forceinline__ void gemm_phase(LAS unsigned char* lds, const int tid, const Sched& S, const Epi& E) {
    constexpr int lda = LD, ldb = LD;
    const int wid = __builtin_amdgcn_readfirstlane(tid >> 6), lane = tid & 63, wr = wid >> 2, wc = wid & 3, fr = lane & 15, fq = lane >> 4;
    constexpr int nt = K / BK;
    unsigned voffA[2];
#pragma unroll
    for (int i = 0; i < 2; ++i) { int R, C; stage_rc(tid * 16 + i * 8192, R, C); voffA[i] = (unsigned)(R * lda + C) * 2u; }
#define voffB voffA
    const size_t kstep = (size_t)(BK * 2);
    const size_t hstepA = (size_t)HALF * lda * 2, hstepB = (size_t)HALF * ldb * 2;
    const unsigned ldsw = (unsigned)wid * 1024u;
    const int aoff = lds_byte(wr * 64 + fr, fq * 8), boff = lds_byte(wc * 32 + fr, fq * 8);
#define PG8_SA(b, h) (((b) * 2 + (h)) * HTB)
#define PG8_SB(b, h) ((4 + (b) * 2 + (h)) * HTB)
#define PG8_STAGE(bufoff, gbase, voff) do { _Pragma("unroll") for (int _i = 0; _i < 2; ++_i) \
        __builtin_amdgcn_global_load_lds((const unsigned*)((const char*)(gbase) + (voff)[_i]), (LAS unsigned*)(lds + (bufoff) + ldsw + _i * 8192), 16, 0, 0); } while (0)
#define PG8_LDA(dst, b, h) do { _Pragma("unroll") for (int m = 0; m < 4; ++m) _Pragma("unroll") for (int k = 0; k < 2; ++k) dst[m][k] = *(const LAS bf16x8*)(lds + PG8_SA(b, h) + aoff + m * 2048 + k * 1024); } while (0)
#define PG8_LDB(dst, b, h) do { _Pragma("unroll") for (int n = 0; n < 2; ++n) _Pragma("unroll") for (int k = 0; k < 2; ++k) dst[n][k] = *(const LAS bf16x8*)(lds + PG8_SB(b, h) + boff + n * 2048 + k * 1024); } while (0)
#define PG8_MMA(ai, bj, At, Bt) do { __builtin_amdgcn_s_setprio(1); _Pragma("unroll") for (int m = 0; m < 4; ++m) _Pragma("unroll") for (int n = 0; n < 2; ++n) _Pragma("unroll") for (int k = 0; k < 2; ++k) \
        acc[ai][bj][m][n] = __builtin_amdgcn_mfma_f32_16x16x32_bf16(Bt[n][k], At[m][k], acc[ai][bj][m][n], 0, 0, 0); __builtin_amdgcn_s_setprio(0); } while (0)
#define PG8_WAIT_V(n) asm volatile("s_waitcnt vmcnt(" #n ")" ::: "memory")
#define PG8_WAIT_L(n) asm volatile("s_waitcnt lgkmcnt(" #n ")" ::: "memory")
#define PG8_BAR __builtin_amdgcn_s_barrier()
#define PG8_SCHED __builtin_amdgcn_sched_barrier(0)
    Unit cur, nxt; int ui = 0;
    if (!S.next(0, cur)) return;
    f32x4 acc[2][2][4][2];
#pragma unroll
    for (int a = 0; a < 2; ++a)
#pragma unroll
        for (int b = 0; b < 2; ++b)
#pragma unroll
            for (int m = 0; m < 4; ++m)
#pragma unroll
                for (int n = 0; n < 2; ++n) acc[a][b][m][n] = (f32x4){0.f, 0.f, 0.f, 0.f};
    bf16x8 At[4][2], B0[2][2], B1[2][2];
    const char* cA = uni_ptr(cur.a); const char* cB = uni_ptr(cur.b);
    PG8_STAGE(PG8_SB(0, 0), cB, voffB); PG8_STAGE(PG8_SB(0, 1), cB + hstepB, voffB); PG8_STAGE(PG8_SA(0, 0), cA, voffA); PG8_STAGE(PG8_SA(0, 1), cA + hstepA, voffA);
    if (wr == 1) PG8_BAR;
    PG8_WAIT_V(2); PG8_BAR;
    PG8_STAGE(PG8_SB(1, 0), cB + kstep, voffB); PG8_STAGE(PG8_SA(1, 0), cA + kstep, voffA); PG8_STAGE(PG8_SB(1, 1), cB + hstepB + kstep, voffB);
    PG8_WAIT_V(6); PG8_BAR;
    for (;;) {
        const bool has_next = S.next(ui + 1, nxt);
        const char* nA = uni_ptr(has_next ? nxt.a : cA); const char* nB = uni_ptr(has_next ? nxt.b : cB);
#pragma clang loop unroll(disable)
        for (int t = 0; t < nt; t += 2) {
            const bool last = (t == nt - 2);
            const char* a1 = cA + (size_t)(t + 1) * kstep;
            const char* a2 = last ? nA : cA + (size_t)(t + 2) * kstep; const char* b2 = last ? nB : cB + (size_t)(t + 2) * kstep;
            const char* a3 = a2 + kstep; const char* b3 = b2 + kstep;
            PG8_LDB(B0, 0, 0); PG8_LDB(B1, 0, 1); PG8_SCHED; PG8_LDA(At, 0, 0); PG8_STAGE(PG8_SA(1, 1), a1 + hstepA, voffA);
            PG8_WAIT_V(8); PG8_WAIT_L(0); PG8_BAR; PG8_MMA(0, 0, At, B0); PG8_MMA(0, 1, At, B1); PG8_BAR; PG8_SCHED;
            PG8_LDA(At, 0, 1); PG8_STAGE(PG8_SB(0, 0), b2, voffB); PG8_STAGE(PG8_SB(0, 1), b2 + hstepB, voffB); PG8_STAGE(PG8_SA(0, 0), a2, voffA);
            PG8_WAIT_V(8); PG8_WAIT_L(0); PG8_BAR; PG8_MMA(1, 0, At, B0); PG8_MMA(1, 1, At, B1); PG8_BAR; PG8_SCHED;
            PG8_LDB(B0, 1, 0); PG8_LDB(B1, 1, 1); PG8_SCHED; PG8_LDA(At, 1, 0); PG8_STAGE(PG8_SA(0, 1), a2 + hstepA, voffA);
            PG8_WAIT_V(8); PG8_WAIT_L(0); PG8_BAR; PG8_MMA(0, 0, At, B0); PG8_MMA(0, 1, At, B1); PG8_BAR; PG8_SCHED;
            PG8_LDA(At, 1, 1); PG8_STAGE(PG8_SB(1, 0), b3, voffB); PG8_STAGE(PG8_SB(1, 1), b3 + hstepB, voffB); PG8_STAGE(PG8_SA(1, 0), a3, voffA);
            PG8_WAIT_V(8); PG8_WAIT_L(0); PG8_BAR; PG8_MMA(1, 0, At, B0); PG8_MMA(1, 1, At, B1); PG8_BAR; PG8_SCHED;
        }
        if constexpr (ALIGN_EPI) { if (wr == 0) PG8_BAR; }
        E(acc, cur, wr, wc, fr, fq, lds, lane);
        if (!has_next) break;
#pragma unroll
        for (int a = 0; a < 2; ++a)
#pragma unroll
            for (int b = 0; b < 2; ++b)
#pragma unroll
                for (int m = 0; m < 4; ++m)
#pragma unroll
                    for (int n = 0; n < 2; ++n) acc[a][b][m][n] = (f32x4){0.f, 0.f, 0.f, 0.f};
        cur = nxt; cA = nA; cB = nB; ++ui;
        if constexpr (ALIGN_EPI) { if (wr == 1) PG8_BAR; }
    }
    PG8_WAIT_V(0);
    if constexpr (!ALIGN_EPI) { if (wr == 0) PG8_BAR; }
    PG8_BAR;
#undef voffB
#undef PG8_SA
#undef PG8_SB
#undef PG8_STAGE
#undef PG8_LDA
#undef PG8_LDB
#undef PG8_MMA
#undef PG8_WAIT_V
#undef PG8_WAIT_L
#undef PG8_BAR
#undef PG8_SCHED
}
}
typedef f32x4 AccT[2][2][4][2];

__host__ __device__ __forceinline__ int slot32(int x) { return 16 * ((x >> 2) & 1) + (x >> 3) * 4 + (x & 3); }
struct EpiIn {
    bf16_t *ZT, *Q, *Kb, *V, *SG; float* GATES;
    __device__ __forceinline__ void operator()(AccT& acc, const pg8::Unit& u, int wr, int wc, int fr, int fq, LAS unsigned char*, int) const {
        const int row0 = u.pm * 256 + wr * 64 + fr;
#pragma unroll
        for (int bj = 0; bj < 2; ++bj) {
            const int colb = u.pn * 256 + bj * 128 + wc * 32;
            if (colb < 512) {
                bf16_t* zt; int ldt, t0;
                if (u.pm < 32) { zt = ZT + (size_t)u.pm * 512 * 256; ldt = 256; t0 = 0; }
                else { const int q = u.pm - 32; zt = ZT + 4194304 + (size_t)(q >> 3) * 512 * 2048; ldt = 2048; t0 = (q & 7) * 256; }
#pragma unroll
                for (int n = 0; n < 2; ++n)
#pragma unroll
                    for (int ai = 0; ai < 2; ++ai)
#pragma unroll
                        for (int m = 0; m < 4; ++m) {
                            const int t = t0 + ai * 128 + wr * 64 + m * 16 + (fr & ~1); const f32x4 v = acc[ai][bj][m][n];
                            const bool odd = fr & 1;
                            const float s0 = odd ? v[0] : v[2], s1 = odd ? v[1] : v[3];
                            const float r0 = dpp_swap1(s0), r1 = dpp_swap1(s1);
                            const unsigned p0 = odd ? cvt_pk_bf16(r0, v[2]) : cvt_pk_bf16(v[0], r0);
                            const unsigned p1 = odd ? cvt_pk_bf16(r1, v[3]) : cvt_pk_bf16(v[1], r1);
                            const int xc = 8 * fq + 4 * n + (odd ? 2 : 0);
                            *(unsigned*)(zt + (size_t)(colb + slot32(xc)) * ldt + t) = p0; *(unsigned*)(zt + (size_t)(colb + slot32(xc + 1)) * ldt + t) = p1;
                        }
            } else {
                bf16_t* dst; int ld, c0; float sc = 1.f; bool act = false;
                if (colb < 768) { dst = Q; ld = 256; c0 = colb - 512; sc = 0.125f; }
                else if (colb < 1024) { dst = Kb; ld = 256; c0 = colb - 768; }
                else if (colb < 1536) { dst = V; ld = 512; c0 = colb - 1024; }
                else { dst = SG; ld = 512; c0 = colb - 1536; act = false; }
                c0 += 8 * fq;
#pragma unroll
                for (int ai = 0; ai < 2; ++ai)
#pragma unroll
                    for (int m = 0; m < 4; ++m) {
                        f32x4 v0 = acc[ai][bj][m][0] * sc, v1 = acc[ai][bj][m][1] * sc;
                        if (act) { v0[0] = silu_f(v0[0]); v0[1] = silu_f(v0[1]); v0[2] = silu_f(v0[2]); v0[3] = silu_f(v0[3]);
                                   v1[0] = silu_f(v1[0]); v1[1] = silu_f(v1[1]); v1[2] = silu_f(v1[2]); v1[3] = silu_f(v1[3]); }
                        u32x4 w; w.x = cvt_pk_bf16(v0[0], v0[1]); w.y = cvt_pk_bf16(v0[2], v0[3]); w.z = cvt_pk_bf16(v1[0], v1[1]); w.w = cvt_pk_bf16(v1[2], v1[3]);
                        *(u32x4*)(dst + (size_t)(row0 + ai * 128 + m * 16) * ld + c0) = w;
                    }
            }
        }
    }
};
__device__ __forceinline__ void gate_rows(LAS unsigned char* lds, int tid, int row0, const bf16_t* H, const bf16_t* Wa, float* GATES) {
    constexpr int RS = 1040;
    constexpr int ABUF = 64 * RS;
    const int wave = tid >> 6, lane = tid & 63, fr = lane & 15, fq = lane >> 4, rt = wave >> 1, ct = wave & 1;
    u32x4 ra[2][8], rw[2][4];
#pragma unroll
    for (int hf = 0; hf < 2; ++hf) {
#pragma unroll
        for (int i = 0; i < 8; ++i) { const int p = tid + 512 * i; ra[hf][i] = *(const u32x4*)(H + (size_t)(row0 + (p >> 6)) * 1024 + hf * 512 + (p & 63) * 8); }
#pragma unroll
        for (int i = 0; i < 4; ++i) { const int p = tid + 512 * i; rw[hf][i] = *(const u32x4*)(Wa + (size_t)(p >> 6) * 1024 + hf * 512 + (p & 63) * 8); }
    }
    f32x4 acc = {0.f, 0.f, 0.f, 0.f};
#pragma unroll
    for (int hf = 0; hf < 2; ++hf) {
        if (hf) __syncthreads();
#pragma unroll
        for (int i = 0; i < 8; ++i) { const int p = tid + 512 * i; *(LAS u32x4*)(lds + (p >> 6) * RS + (p & 63) * 16) = ra[hf][i]; }
#pragma unroll
        for (int i = 0; i < 4; ++i) { const int p = tid + 512 * i; *(LAS u32x4*)(lds + ABUF + (p >> 6) * RS + (p & 63) * 16) = rw[hf][i]; }
        __syncthreads();
#pragma unroll
        for (int kk = 0; kk < 16; ++kk) { const bf16x8 hv = *(const LAS bf16x8*)(lds + (rt * 16 + fr) * RS + kk * 64 + fq * 16), wv = *(const LAS bf16x8*)(lds + ABUF + (ct * 16 + fr) * RS + kk * 64 + fq * 16);
            acc = __builtin_amdgcn_mfma_f32_16x16x32_bf16(wv, hv, acc, 0, 0, 0); }
    }
    *(f32x4*)(GATES + (size_t)(row0 + rt * 16 + fr) * 32 + ct * 16 + fq * 4) = acc;
    __syncthreads();
}
struct EpiY {
    float* Y; float* SSQ;
    __device__ __forceinline__ void operator()(AccT& acc, const pg8::Unit& u, int wr, int wc, int fr, int fq, LAS unsigned char*, int) const {
        const int row0 = u.pm * 256 + wr * 64 + fr, col0 = u.pn * 256 + wc * 32 + 4 * fq;
#pragma unroll
        for (int ai = 0; ai < 2; ++ai)
#pragma unroll
            for (int m = 0; m < 4; ++m) {
                const int r = row0 + ai * 128 + m * 16; float s = 0.f;
#pragma unroll
                for (int bj = 0; bj < 2; ++bj)
#pragma unroll
                    for (int n = 0; n < 2; ++n) { const f32x4 v = acc[ai][bj][m][n]; s += (v[0] * v[0] + v[1] * v[1]) + (v[2] * v[2] + v[3] * v[3]);
                        *(f32x4*)(Y + (size_t)r * DM + col0 + bj * 128 + n * 16) = v; }
                s += __shfl_xor(s, 16); s += __shfl_xor(s, 32);
                if (fq == 0) SSQ[(size_t)r * 16 + u.pn * 4 + wc] = s;
            }
    }
};
struct EpiStore {
    static constexpr int ld = KOUT;
    __device__ __forceinline__ void operator()(AccT& acc, const pg8::Unit& u, int wr, int wc, int fr, int fq, LAS unsigned char*, int) const {
        bf16_t* o = (bf16_t*)u.o;
#pragma unroll
        for (int ai = 0; ai < 2; ++ai)
#pragma unroll
            for (int m = 0; m < 4; ++m) {
                const int r = ai * 128 + wr * 64 + m * 16 + fr;
#pragma unroll
                for (int bj = 0; bj < 2; ++bj) { const f32x4 v0 = acc[ai][bj][m][0], v1 = acc[ai][bj][m][1];
                    u32x4 w; w.x = cvt_pk_bf16(v0[0], v0[1]); w.y = cvt_pk_bf16(v0[2], v0[3]); w.z = cvt_pk_bf16(v1[0], v1[1]); w.w = cvt_pk_bf16(v1[2], v1[3]);
                    *(u32x4*)(o + (size_t)r * ld + bj * 128 + wc * 32 + 8 * fq) = w; }
            }
    }
};
struct EpiConv {
    bf16_t* ACT; const float* cw; const float* cb;
    __device__ __forceinline__ void operator()(AccT& acc, const pg8::Unit& u, int wr, int wc, int fr, int fq, LAS unsigned char* lds, int lane) const {
        int zo_ = 0; asm volatile("" : "+s"(zo_));
        LAS float* XB = (LAS float*)(lds + XCH_OFF + zo_);
        const bool is_ctx = u.pm < 32;
        (void)lane;
        const int cl0 = wc * 32 + 8 * fq;
        if (is_ctx) {
#pragma unroll
        for (int ai = 0; ai < 2; ++ai) { const int blk = 2 * ai + wr;
#pragma unroll
            for (int bj = 0; bj < 2; ++bj)
#pragma unroll
                for (int n = 0; n < 2; ++n) { const int cl = cl0 + 4 * n;
                    if (fr == 0) *(LAS f32x4*)(XB + ((blk * 2 + 0) * 2 + bj) * 128 + cl) = acc[ai][bj][0][n];
                    if (fr == 15) *(LAS f32x4*)(XB + ((blk * 2 + 1) * 2 + bj) * 128 + cl) = acc[ai][bj][3][n]; } }
        asm volatile("s_waitcnt lgkmcnt(0)" ::: "memory"); __builtin_amdgcn_s_barrier(); asm volatile("" ::: "memory");
        }
        f32x4 w0[2][2], w1[2][2]; u32x2 w2p[2][2], bbp[2][2];
#pragma unroll
        for (int n = 0; n < 2; ++n)
#pragma unroll
            for (int bj = 0; bj < 2; ++bj) { const int gc = bj * DFF + u.pn * 128 + cl0 + 4 * n;
                w0[n][bj] = *(const f32x4*)(cw + gc); w1[n][bj] = *(const f32x4*)(cw + NUP + gc); { const f32x4 t4 = *(const f32x4*)(cw + 2 * NUP + gc); w2p[n][bj].x = cvt_pk_bf16(t4[0], t4[1]); w2p[n][bj].y = cvt_pk_bf16(t4[2], t4[3]); }
                const f32x4 b4 = *(const f32x4*)(cb + gc); bbp[n][bj].x = cvt_pk_bf16(b4[0], b4[1]); bbp[n][bj].y = cvt_pk_bf16(b4[2], b4[3]); }
#pragma unroll
        for (int ai = 0; ai < 2; ++ai) { const int blk = 2 * ai + wr;
#pragma unroll
            for (int m = 0; m < 4; ++m) {
                unsigned pq[2][2];
#pragma unroll
                for (int n = 0; n < 2; ++n) {
                    f32x4 cv[2];
#pragma unroll
                    for (int bj = 0; bj < 2; ++bj) {
                        const f32x4 cur = acc[ai][bj][m][n]; f32x4 up, dn;
                        f32x4 eu = {0.f, 0.f, 0.f, 0.f}, ed = {0.f, 0.f, 0.f, 0.f};
                        if (m == 0 && is_ctx && blk > 0) eu = *(LAS f32x4*)(XB + (((blk - 1) * 2 + 1) * 2 + bj) * 128 + cl0 + 4 * n);
                        if (m == 3 && is_ctx && blk < 3) ed = *(LAS f32x4*)(XB + (((blk + 1) * 2 + 0) * 2 + bj) * 128 + cl0 + 4 * n);
#pragma unroll
                        for (int j = 0; j < 4; ++j) {
                            const float su = (fr == 15 && m > 0) ? acc[ai][bj][m > 0 ? m - 1 : 0][n][j] : cur[j];
                            const float sd = (fr == 0 && m < 3) ? acc[ai][bj][m < 3 ? m + 1 : 3][n][j] : cur[j];
                            float u_ = dpp_ror1(su), d_ = dpp_rol1(sd);
                            if (m == 0) u_ = (fr == 0) ? eu[j] : u_;
                            if (m == 3) d_ = (fr == 15) ? ed[j] : d_;
                            up[j] = u_; dn[j] = d_;
                        }
                        const u32x2 bp = bbp[n][bj];
                        const f32x4 bb = {bf2f(bp.x & 0xffffu), bf2f(bp.x >> 16), bf2f(bp.y & 0xffffu), bf2f(bp.y >> 16)};
                        const u32x2 wp = w2p[n][bj];
                        const f32x4 w2 = {bf2f(wp.x & 0xffffu), bf2f(wp.x >> 16), bf2f(wp.y & 0xffffu), bf2f(wp.y >> 16)};
                        cv[bj] = w0[n][bj] * up + w1[n][bj] * cur + w2 * dn + bb;
                    }
                    const unsigned p0 = cvt_pk_bf16(silu_f(cv[1][0]) * cv[0][0], silu_f(cv[1][1]) * cv[0][1]), p1 = cvt_pk_bf16(silu_f(cv[1][2]) * cv[0][2], silu_f(cv[1][3]) * cv[0][3]);
                    pq[n][0] = p0; pq[n][1] = p1;
                }
                const u32x4 w4 = {pq[0][0], pq[0][1], pq[1][0], pq[1][1]};
                *(u32x4*)(ACT + (size_t)(u.pm * 256 + ai * 128 + wr * 64 + m * 16 + fr) * DFF + u.pn * 128 + cl0) = w4;
            }
        }
    }
};
#define RLX_AGENT __ATOMIC_RELAXED, __HIP_MEMORY_SCOPE_AGENT
__device__ __forceinline__ void panel_exchange(const float (&ps)[2][4], float (&rs)[2][4], int wr, int wc, int fr, int fq, int tid, LAS unsigned char* lds, unsigned* xslot, unsigned* cnt, int pn) {
    LAS float* P = (LAS float*)(lds + XCH_OFF); LAS float* S = (LAS float*)(lds + XCH_OFF + 4096);
#pragma unroll
    for (int ai = 0; ai < 2; ++ai)
#pragma unroll
        for (int m = 0; m < 4; ++m) if (fq == 0) P[(ai * 128 + wr * 64 + m * 16 + fr) * 4 + wc] = ps[ai][m];
    asm volatile("s_waitcnt lgkmcnt(0)" ::: "memory"); __builtin_amdgcn_s_barrier(); asm volatile("" ::: "memory");
    if (tid < 256) { const f32x4 p = *(const LAS f32x4*)(P + tid * 4); __hip_atomic_store(xslot + pn * 256 + tid, __float_as_uint((p[0] + p[1]) + (p[2] + p[3])), RLX_AGENT); }
    asm volatile("s_waitcnt vmcnt(0) lgkmcnt(0)" ::: "memory"); __builtin_amdgcn_s_barrier(); asm volatile("" ::: "memory");
    if (tid == 0) { __hip_atomic_fetch_add(cnt, 1u, RLX_AGENT); unsigned sp = 0;
        while (__hip_atomic_load(cnt, RLX_AGENT) < 4u) { __builtin_amdgcn_s_sleep(1); if (++sp > (1u << 22)) break; }
        __builtin_amdgcn_fence(__ATOMIC_ACQUIRE, "agent"); }
    asm volatile("s_waitcnt vmcnt(0) lgkmcnt(0)" ::: "memory"); __builtin_amdgcn_s_barrier(); asm volatile("" ::: "memory");
    if (tid < 256) { float t = 0.f;
#pragma unroll
        for (int q = 0; q < 4; ++q) t += __uint_as_float(__hip_atomic_load(xslot + q * 256 + tid, RLX_AGENT));
        S[tid] = __builtin_amdgcn_rsqf(t * (1.f / 1024.f) + EPS); }
    asm volatile("s_waitcnt vmcnt(0) lgkmcnt(0)" ::: "memory"); __builtin_amdgcn_s_barrier(); asm volatile("" ::: "memory");
#pragma unroll
    for (int ai = 0; ai < 2; ++ai)
#pragma unroll
        for (int m = 0; m < 4; ++m) rs[ai][m] = S[ai * 128 + wr * 64 + m * 16 + fr];
}
__device__ __forceinline__ void row_ssq(const AccT& acc, float (&ps)[2][4]) {
#pragma unroll
    for (int ai = 0; ai < 2; ++ai)
#pragma unroll
        for (int m = 0; m < 4; ++m) { float s = 0.f;
#pragma unroll
            for (int bj = 0; bj < 2; ++bj)
#pragma unroll
                for (int n = 0; n < 2; ++n) { const f32x4 v = acc[ai][bj][m][n]; s += (v[0] * v[0] + v[1] * v[1]) + (v[2] * v[2] + v[3] * v[3]); }
            s += __shfl_xor(s, 16); s += __shfl_xor(s, 32); ps[ai][m] = s; }
}
struct EpiRows {
    float* OUTF; bf16_t* XB; bf16_t* H; const float* MOD; const float* g_post; const float* g_pre;
    int l_gate, slot_gate, l_h, slot_scale, slot_shift; bool do_h;
    unsigned* xbuf; unsigned* cnt;
    __device__ __forceinline__ void operator()(AccT& acc, const pg8::Unit& u, int wr, int wc, int fr, int fq, LAS unsigned char* lds, int lane) const {
        const int tid = (wr * 4 + wc) * 64 + lane;
        const int cond = u.pm < 32 ? 0 : 1 + ((u.pm - 32) >> 3);
        const int row0 = u.pm * 256 + wr * 64 + fr, col0 = u.pn * 256 + wc * 32 + 8 * fq;
        float ps[2][4], rs[2][4];
        row_ssq(acc, ps);
        panel_exchange(ps, rs, wr, wc, fr, fq, tid, lds, xbuf + (size_t)(0 * 64 + u.pm) * 1024, cnt + (0 * 64 + u.pm) * 64, u.pn);
        const float* gatev = MOD + (size_t)((l_gate * 5 + cond) * 6 + slot_gate) * 1024;
#pragma unroll
        for (int bj = 0; bj < 2; ++bj) { const int c = col0 + bj * 128;
            const f32x4 gg0 = *(const f32x4*)(gatev + c) * *(const f32x4*)(g_post + c), gg1 = *(const f32x4*)(gatev + c + 4) * *(const f32x4*)(g_post + c + 4);
#pragma unroll
            for (int ai = 0; ai < 2; ++ai)
#pragma unroll
                for (int m = 0; m < 4; ++m) { const size_t off = (size_t)(row0 + ai * 128 + m * 16) * DM + c;
                    const u32x4 xb = *(const u32x4*)(XB + off);
                    const f32x4 xo0 = {bf2f(xb.x & 0xffffu), bf2f(xb.x >> 16), bf2f(xb.y & 0xffffu), bf2f(xb.y >> 16)};
                    const f32x4 xo1 = {bf2f(xb.z & 0xffffu), bf2f(xb.z >> 16), bf2f(xb.w & 0xffffu), bf2f(xb.w >> 16)};
                    const f32x4 xn0 = xo0 + gg0 * (acc[ai][bj][m][0] * rs[ai][m]), xn1 = xo1 + gg1 * (acc[ai][bj][m][1] * rs[ai][m]);
                    acc[ai][bj][m][0] = xn0; acc[ai][bj][m][1] = xn1;
                    if (OUTF) { *(f32x4*)(OUTF + off) = xn0; *(f32x4*)(OUTF + off + 4) = xn1; }
                    else { u32x4 w; w.x = cvt_pk_bf16(xn0[0], xn0[1]); w.y = cvt_pk_bf16(xn0[2], xn0[3]); w.z = cvt_pk_bf16(xn1[0], xn1[1]); w.w = cvt_pk_bf16(xn1[2], xn1[3]); *(u32x4*)(XB + off) = w; } } }
        if (do_h) {
            row_ssq(acc, ps);
            panel_exchange(ps, rs, wr, wc, fr, fq, tid, lds, xbuf + (size_t)(1 * 64 + u.pm) * 1024, cnt + (1 * 64 + u.pm) * 64, u.pn);
            const float* mb = MOD + (size_t)((l_h * 5 + cond) * 6) * 1024;
#pragma unroll
            for (int bj = 0; bj < 2; ++bj) { const int c = col0 + bj * 128;
                const f32x4 gs0 = *(const f32x4*)(g_pre + c) * (*(const f32x4*)(mb + slot_scale * 1024 + c) + 1.0f), sh0 = *(const f32x4*)(mb + slot_shift * 1024 + c);
                const f32x4 gs1 = *(const f32x4*)(g_pre + c + 4) * (*(const f32x4*)(mb + slot_scale * 1024 + c + 4) + 1.0f), sh1 = *(const f32x4*)(mb + slot_shift * 1024 + c + 4);
#pragma unroll
                for (int ai = 0; ai < 2; ++ai)
#pragma unroll
                    for (int m = 0; m < 4; ++m) { const f32x4 h0 = acc[ai][bj][m][0] * rs[ai][m] * gs0 + sh0, h1 = acc[ai][bj][m][1] * rs[ai][m] * gs1 + sh1;
                        u32x4 w; w.x = cvt_pk_bf16(h0[0], h0[1]); w.y = cvt_pk_bf16(h0[2], h0[3]); w.z = cvt_pk_bf16(h1[0], h1[1]); w.w = cvt_pk_bf16(h1[2], h1[3]);
                        *(u32x4*)(H + (size_t)(row0 + ai * 128 + m * 16) * DM + c) = w; } }
        }
    }
};
struct DftOrder {
    const char *D, *ZT; char* A2; int G, c; bool smp;
    __device__ bool next(int i, pg8::Unit& u) const {
        const int L = i * G + c; if (L >= 128) return false;
        if (smp) { const int b = L >> 5, mt = (L >> 1) & 15, nt = L & 1;
            u.a = D + (size_t)mt * 256 * 2048 * 2; u.b = ZT + ((size_t)(b * 512 + nt * 256) * 2048) * 2;
            u.o = A2 + ((size_t)(NCTX + b * 2048 + (mt & 7) * 256) * KOUT + (mt >> 3) * 512 + nt * 256) * 2; u.pm = mt; u.pn = nt; }
        else { const int b = L >> 2, mt = (L >> 1) & 1, nt = L & 1;
            u.a = D + (size_t)mt * 256 * 256 * 2; u.b = ZT + ((size_t)(b * 512 + nt * 256) * 256) * 2;
            u.o = A2 + ((size_t)(b * 256) * KOUT + mt * 512 + nt * 256) * 2; u.pm = mt; u.pn = nt; }
        return true;
    }
};

struct Args { const float* in[22]; float* out; unsigned char* ws; int ph_lo, ph_hi; };
struct Frame {
    LAS unsigned char* lds; int tid, lane, wave, G, bid;
    const float* const* in; float* out; unsigned char* ws;
};
#define IN_XP 0
#define IN_XS 1
#define IN_STATE 2
#define IN_C 3
#define IN_CCTX 4
#define IN_GPM 5
#define IN_GQM 6
#define IN_GPF 7
#define IN_GQF 8
#define IN_WADA 9
#define IN_BADA 10
#define IN_WIN 11
#define IN_WGF 12
#define IN_BGF 13
#define IN_WGB 14
#define IN_BGB 15
#define IN_GGLA 16
#define IN_WOUT 17
#define IN_WUP 18
#define IN_CW 19
#define IN_CB 20
#define IN_WDN 21

__device__ __forceinline__ void transpose_item(const float* W, int ldw, int nblk, bf16_t* WT, int ldt, int koff, int mode, LAS float* scr, int item, int lane) {
    const int kb = item / nblk, nb = item % nblk, k0 = 64 * kb, n0 = 32 * nb;
#pragma unroll 8
    for (int i = 0; i < 32; ++i) { const int kk = 2 * i + (lane >> 5); scr[kk * 33 + (lane & 31)] = W[(size_t)(k0 + kk) * ldw + n0 + (lane & 31)]; }
    asm volatile("s_waitcnt lgkmcnt(0)" ::: "memory");
    const int c = lane & 7;
#pragma unroll
    for (int j = 0; j < 4; ++j) { const int n = (lane >> 3) + 8 * j; const LAS float* s = scr + (8 * c) * 33 + n;
        u32x4 o; o.x = cvt_pk_bf16(s[0 * 33], s[1 * 33]); o.y = cvt_pk_bf16(s[2 * 33], s[3 * 33]); o.z = cvt_pk_bf16(s[4 * 33], s[5 * 33]); o.w = cvt_pk_bf16(s[6 * 33], s[7 * 33]);
        int nn = n0 + n, drow = nn;
        if (mode == 1) { const int g = nn >= DFF ? 1 : 0, jj = nn - g * DFF; drow = (jj >> 7) * 256 + g * 128 + (jj & 127);
            const int x = drow & 31; drow = (drow & ~31) + 16 * ((x >> 2) & 1) + (x >> 3) * 4 + (x & 3); }
        if (mode == 3) { const int x = nn & 31; drow = (nn & ~31) + 16 * ((x >> 2) & 1) + (x >> 3) * 4 + (x & 3); }
        if (mode == 2) { drow = nn < 1536 ? nn : (nn < 1568 ? 2048 + (nn - 1536) : nn - 32);
            if (drow < 2048) { const int x = drow & 31; drow = (drow & ~31) + 16 * ((x >> 2) & 1) + (x >> 3) * 4 + (x & 3); } }
        *(u32x4*)(WT + (size_t)drow * ldt + koff + k0 + 8 * c) = o; }
    asm volatile("s_waitcnt lgkmcnt(0)" ::: "memory");
}

__device__ __forceinline__ void prep_conv_item(const Frame& F, int it, LAS float* scr, const LAS float* TAB) {
    bf16_t* Win_t = (bf16_t*)(F.ws + WS_WIN); bf16_t* Wout_t = (bf16_t*)(F.ws + WS_WOUT); bf16_t* Wup_t = (bf16_t*)(F.ws + WS_WUP); bf16_t* Wdn_t = (bf16_t*)(F.ws + WS_WDN);
    bf16_t* DS = (bf16_t*)(F.ws + WS_DS); bf16_t* DC = (bf16_t*)(F.ws + WS_DC);
    constexpr int I_IN = 16 * 65, I_PAD = 224, I_UP = 16 * 176, I_DN = 44 * 32, I_OG = 8 * 32, I_FOLD = 4 * 16 * 16;
    constexpr int PER_L = I_IN + I_PAD + I_UP + I_DN + I_OG + I_FOLD;
    constexpr int I_DSM = 4096 * 4, I_DCM = 256;
    constexpr int NITEMS = 2 * PER_L + I_DSM + I_DCM;
    int r = it;
        if (r < 2 * PER_L) {
            const int l = r / PER_L; r -= l * PER_L;
            if (r < I_IN) { transpose_item(F.in[IN_WIN] + (size_t)l * 1024 * 2080, 2080, 65, Win_t + (size_t)l * N1 * 1024, 1024, 0, 2, scr, r, F.lane); return; } r -= I_IN;
            if (r < I_PAD) { u32x4 z = {0u, 0u, 0u, 0u}; u32x4* p = (u32x4*)(Win_t + ((size_t)l * N1 + 2080 + r) * 1024); p[F.lane] = z; p[64 + F.lane] = z; return; } r -= I_PAD;
            if (r < I_UP) { transpose_item(F.in[IN_WUP] + (size_t)l * 1024 * NUP, NUP, 176, Wup_t + (size_t)l * NUP * 1024, 1024, 0, 1, scr, r, F.lane); return; } r -= I_UP;
            if (r < I_DN) { transpose_item(F.in[IN_WDN] + (size_t)l * DFF * 1024, 1024, 32, Wdn_t + (size_t)l * 1024 * DFF, DFF, 0, 3, scr, r, F.lane); return; } r -= I_DN;
            if (r < I_OG) { transpose_item(F.in[IN_WOUT] + ((size_t)l * 1024 + 512) * 1024, 1024, 32, Wout_t + (size_t)l * 1024 * KOUT, KOUT, 1024, 3, scr, r, F.lane); return; } r -= I_OG;
            {
                const int h = r >> 8, cbk = (r >> 4) & 15, nb = r & 15, n = nb * 64 + F.lane;
                const float* wp = F.in[IN_WOUT] + ((size_t)l * 1024 + h * 128) * 1024 + n;
                float ac[8], as[8];
#pragma unroll
                for (int e = 0; e < 8; ++e) { ac[e] = 0.f; as[e] = 0.f; }
#pragma unroll 16
                for (int cp = 0; cp < 128; ++cp) { const float w = wp[(size_t)cp * 1024];
#pragma unroll
                    for (int e = 0; e < 8; ++e) { const int idx = ((cbk * 8 + e) * cp) & 127; ac[e] += TAB[idx] * w; as[e] += TAB[128 + idx] * w; } }
                const float sc = 0.08838834764831845f;
                u32x4 oc, os;
                oc.x = cvt_pk_bf16(ac[0] * sc, ac[1] * sc); oc.y = cvt_pk_bf16(ac[2] * sc, ac[3] * sc); oc.z = cvt_pk_bf16(ac[4] * sc, ac[5] * sc); oc.w = cvt_pk_bf16(ac[6] * sc, ac[7] * sc);
                os.x = cvt_pk_bf16(-as[0] * sc, -as[1] * sc); os.y = cvt_pk_bf16(-as[2] * sc, -as[3] * sc); os.z = cvt_pk_bf16(-as[4] * sc, -as[5] * sc); os.w = cvt_pk_bf16(-as[6] * sc, -as[7] * sc);
                const int xn_ = n & 31, nrow = (n & ~31) + 16 * ((xn_ >> 2) & 1) + (xn_ >> 3) * 4 + (xn_ & 3);
                bf16_t* dst = Wout_t + ((size_t)l * 1024 + nrow) * KOUT + h * 128 + cbk * 8;
                *(u32x4*)dst = oc; *(u32x4*)(dst + 512) = os;
            }
            return;
        }
        r -= 2 * PER_L;
        if (r < I_DSM) { const int m = r >> 2, k0 = (r & 3) * 512 + F.lane * 8, part = m >> 11, tp = m & 2047; float v[8];
#pragma unroll
            for (int e = 0; e < 8; ++e) { const float x = (float)((tp * (k0 + e)) & 2047) * (1.f / 2048.f); v[e] = (part ? __builtin_amdgcn_sinf(x) : __builtin_amdgcn_cosf(x)) * 0.022097086912079608f; }
            u32x4 o; o.x = cvt_pk_bf16(v[0], v[1]); o.y = cvt_pk_bf16(v[2], v[3]); o.z = cvt_pk_bf16(v[4], v[5]); o.w = cvt_pk_bf16(v[6], v[7]);
            *(u32x4*)(DS + (size_t)m * 2048 + k0) = o; return; }
        r -= I_DSM;
        { const int m = r * 2 + (F.lane >> 5), k0 = (F.lane & 31) * 8, part = m >> 8, tp = m & 255; float v[8];
#pragma unroll
            for (int e = 0; e < 8; ++e) { const float x = (float)((tp * (k0 + e)) & 255) * (1.f / 256.f); v[e] = (part ? __builtin_amdgcn_sinf(x) : __builtin_amdgcn_cosf(x)) * 0.0625f; }
            u32x4 o; o.x = cvt_pk_bf16(v[0], v[1]); o.y = cvt_pk_bf16(v[2], v[3]); o.z = cvt_pk_bf16(v[4], v[5]); o.w = cvt_pk_bf16(v[6], v[7]);
            *(u32x4*)(DC + (size_t)m * 256 + k0) = o; }
    }

__device__ __forceinline__ void row0_item(const Frame& F, int r) {
    const float* MOD = (const float*)(F.ws + WS_MOD); bf16_t* H = (bf16_t*)(F.ws + WS_H);
    const int cond = r < NCTX ? 0 : 1 + ((r - NCTX) >> 11);
    f32x4 x[4];
    const f32x4* src = (const f32x4*)(r < NCTX ? F.in[IN_XP] + (size_t)r * DM : F.in[IN_XS] + (size_t)(r - NCTX) * DM) + F.lane;
#pragma unroll
    for (int j = 0; j < 4; ++j) x[j] = src[64 * j];
    if (r >= NCTX) { const int t = (r - NCTX) & 2047; const float pr = (float)(t >> 6), pc = (float)(t & 63);
#pragma unroll
        for (int k = 0; k < 4; ++k) { const float q = (float)(4 * F.lane + k); const float om = __builtin_amdgcn_exp2f(q * (-13.287712379549449f / 256.f)) * 0.15915494309189535f;
            const float ar = pr * om, ac = pc * om;
            x[0][k] += __builtin_amdgcn_sinf(ar - floorf(ar)); x[1][k] += __builtin_amdgcn_cosf(ar - floorf(ar));
            x[2][k] += __builtin_amdgcn_sinf(ac - floorf(ac)); x[3][k] += __builtin_amdgcn_cosf(ac - floorf(ac)); } }
    { u32x2* xo = (u32x2*)((bf16_t*)(F.ws + WS_XRB) + (size_t)r * DM) + F.lane;
#pragma unroll
      for (int j = 0; j < 4; ++j) { u32x2 w; w.x = cvt_pk_bf16(x[j][0], x[j][1]); w.y = cvt_pk_bf16(x[j][2], x[j][3]); xo[64 * j] = w; } }
    float ss = 0.f;
#pragma unroll
    for (int j = 0; j < 4; ++j) ss += (x[j][0] * x[j][0] + x[j][1] * x[j][1]) + (x[j][2] * x[j][2] + x[j][3] * x[j][3]);
    const float rx = __builtin_amdgcn_rsqf(wave_sum(ss) * (1.f / 1024.f) + EPS);
    const float* mb = MOD + (size_t)cond * 6144;
    const f32x4* shp = (const f32x4*)mb + F.lane; const f32x4* scp = (const f32x4*)(mb + 1024) + F.lane; const f32x4* gp = (const f32x4*)F.in[IN_GPM] + F.lane;
    u32x2* ho = (u32x2*)(H + (size_t)r * DM) + F.lane;
#pragma unroll
    for (int j = 0; j < 4; ++j) { const f32x4 hv = x[j] * rx * gp[64 * j] * (scp[64 * j] + 1.0f) + shp[64 * j];
        u32x2 w; w.x = cvt_pk_bf16(hv[0], hv[1]); w.y = cvt_pk_bf16(hv[2], hv[3]); ho[64 * j] = w; }
}

__device__ __forceinline__ void prep_gemv(const Frame& F) {
    LAS float* SC = (LAS float*)(F.lds + 72 * 1024);
    LAS float* RED = (LAS float*)(F.lds + 92 * 1024);
    LAS float* TAB = (LAS float*)(F.lds + 104 * 1024);
    const float* c = F.in[IN_C]; const float* cctx = F.in[IN_CCTX];
    for (int e = F.tid; e < 5120; e += 512) { const float v = e < 1024 ? cctx[e] : c[e - 1024]; SC[e] = silu_f(v); }
    if (F.tid < 128) { TAB[F.tid] = __builtin_amdgcn_cosf((float)F.tid * (1.f / 128.f)); TAB[128 + F.tid] = __builtin_amdgcn_sinf((float)F.tid * (1.f / 128.f)); }
    __syncthreads();
    float* MOD = (float*)(F.ws + WS_MOD);
    for (int it = F.bid; it < 384; it += F.G) {
        const int l = it / 192, cbk = it % 192;
        const int cl = F.lane & 31, kh = F.lane >> 5, col = cbk * 32 + cl, kbase = F.wave * 128 + kh * 64;
        const float* wp = F.in[IN_WADA] + ((size_t)l * 1024 + kbase) * 6144 + col;
        float a0 = 0.f, a1 = 0.f, a2 = 0.f, a3 = 0.f, a4 = 0.f;
#pragma unroll 16
        for (int kk = 0; kk < 64; ++kk) { const float w = wp[(size_t)kk * 6144]; const int k = kbase + kk;
            a0 += SC[k] * w; a1 += SC[1024 + k] * w; a2 += SC[2048 + k] * w; a3 += SC[3072 + k] * w; a4 += SC[4096 + k] * w; }
        const int slot = F.wave * 2 + kh;
        RED[(slot * 5 + 0) * 32 + cl] = a0; RED[(slot * 5 + 1) * 32 + cl] = a1; RED[(slot * 5 + 2) * 32 + cl] = a2;
        RED[(slot * 5 + 3) * 32 + cl] = a3; RED[(slot * 5 + 4) * 32 + cl] = a4;
        __syncthreads();
        if (F.tid < 160) { const int cnd = F.tid >> 5, ln = F.tid & 31; float s = 0.f;
#pragma unroll
            for (int w = 0; w < 16; ++w) s += RED[(w * 5 + cnd) * 32 + ln];
            const int cc = cbk * 32 + ln;
            MOD[(size_t)(l * 5 + cnd) * 6144 + cc] = s + F.in[IN_BADA][l * 6144 + cc]; }
        __syncthreads();
    }
}

__device__ __forceinline__ void prep_rest(const Frame& F) {
    LAS float* TAB = (LAS float*)(F.lds + 104 * 1024);
    if (F.tid < 128) { TAB[F.tid] = __builtin_amdgcn_cosf((float)F.tid * (1.f / 128.f)); TAB[128 + F.tid] = __builtin_amdgcn_sinf((float)F.tid * (1.f / 128.f)); }
    __syncthreads();
    LAS float* scr = (LAS float*)(F.lds + F.wave * 8448);
    const int gw = F.bid * 8 + F.wave, NGW = F.G * 8;
    constexpr int NCONV = 30176;
    int cidx = 0, ridx = 0;
    for (int k = 0; ; ++k) {
        const int rr = ridx * NGW + gw, it = cidx * NGW + gw;
        if ((k % 3 == 2 || it >= NCONV) && rr < MTOK) { row0_item(F, rr); ++ridx; continue; }
        if (it < NCONV) { prep_conv_item(F, it, scr, TAB); ++cidx; continue; }
        break;
    }
}

__device__ __forceinline__ void row_phase(const Frame& F, int l, int kind, const float* Y) {
    const float* MOD = (const float*)(F.ws + WS_MOD); const float* SSQ = (const float*)(F.ws + WS_SSQ);
    bf16_t* H = (bf16_t*)(F.ws + WS_H); float* XR = F.out;
    const int gw = F.bid * 8 + F.wave, NGW = F.G * 8;
    for (int r = gw; r < MTOK; r += NGW) {
        const int cond = r < NCTX ? 0 : 1 + ((r - NCTX) >> 11);
        f32x4 x[4];
        if (kind == 0) {
            const f32x4* src = (const f32x4*)(r < NCTX ? F.in[IN_XP] + (size_t)r * DM : F.in[IN_XS] + (size_t)(r - NCTX) * DM) + F.lane;
#pragma unroll
            for (int j = 0; j < 4; ++j) x[j] = src[64 * j];
            if (r >= NCTX) { const int t = (r - NCTX) & 2047; const float pr = (float)(t >> 6), pc = (float)(t & 63);
#pragma unroll
                for (int k = 0; k < 4; ++k) { const float q = (float)(4 * F.lane + k); const float om = __builtin_amdgcn_exp2f(q * (-13.287712379549449f / 256.f)) * 0.15915494309189535f;
                    const float ar = pr * om, ac = pc * om;
                    x[0][k] += __builtin_amdgcn_sinf(ar - floorf(ar)); x[1][k] += __builtin_amdgcn_cosf(ar - floorf(ar));
                    x[2][k] += __builtin_amdgcn_sinf(ac - floorf(ac)); x[3][k] += __builtin_amdgcn_cosf(ac - floorf(ac)); } }
        } else {
            const f32x4* sp = (const f32x4*)(SSQ + (size_t)r * 16); const f32x4 s4 = (sp[0] + sp[1]) + (sp[2] + sp[3]);
            const float ry = __builtin_amdgcn_rsqf(((s4[0] + s4[1]) + (s4[2] + s4[3])) * (1.f / 1024.f) + EPS);
            const f32x4* yp = (const f32x4*)(Y + (size_t)r * DM) + F.lane; const f32x4* xp = (const f32x4*)(XR + (size_t)r * DM) + F.lane;
            const f32x4* gp = (const f32x4*)(MOD + (size_t)(l * 5 + cond) * 6144 + (kind == 1 ? 2 : 5) * 1024) + F.lane;
            const f32x4* gq = (const f32x4*)(F.in[kind == 1 ? IN_GQM : IN_GQF] + l * 1024) + F.lane;
#pragma unroll
            for (int j = 0; j < 4; ++j) x[j] = xp[64 * j] + gp[64 * j] * (yp[64 * j] * ry * gq[64 * j]);
        }
        { u32x2* xo = (u32x2*)((bf16_t*)(F.ws + WS_XRB) + (size_t)r * DM) + F.lane;
#pragma unroll
          for (int j = 0; j < 4; ++j) { u32x2 w; w.x = cvt_pk_bf16(x[j][0], x[j][1]); w.y = cvt_pk_bf16(x[j][2], x[j][3]); xo[64 * j] = w; } }
        const int lh = kind == 2 ? l + 1 : l;
        if (lh < DEPTH) {
            float ss = 0.f;
#pragma unroll
            for (int j = 0; j < 4; ++j) ss += (x[j][0] * x[j][0] + x[j][1] * x[j][1]) + (x[j][2] * x[j][2] + x[j][3] * x[j][3]);
            const float rx = __builtin_amdgcn_rsqf(wave_sum(ss) * (1.f / 1024.f) + EPS);
            const float* mb = MOD + (size_t)(lh * 5 + cond) * 6144;
            const f32x4* shp = (const f32x4*)(mb + (kind == 1 ? 3 : 0) * 1024) + F.lane; const f32x4* scp = (const f32x4*)(mb + (kind == 1 ? 4 : 1) * 1024) + F.lane;
            const f32x4* gp = (const f32x4*)(F.in[kind == 1 ? IN_GPF : IN_GPM] + lh * 1024) + F.lane;
            u32x2* ho = (u32x2*)(H + (size_t)r * DM) + F.lane;
#pragma unroll
            for (int j = 0; j < 4; ++j) { const f32x4 hv = x[j] * rx * gp[64 * j] * (scp[64 * j] + 1.0f) + shp[64 * j];
                u32x2 w; w.x = cvt_pk_bf16(hv[0], hv[1]); w.y = cvt_pk_bf16(hv[2], hv[3]); ho[64 * j] = w; }
        }
    }
}

constexpr int GL_ZA = 0, GL_TOT = 8192, GL_RS = 10240, GL_QT = 11264, GL_KT = 29696, GL_VT = 48128, GL_X = 66560, GL_ST = 84992;
__device__ __forceinline__ float logsig(float x) { return fminf(x, 0.f) - __logf(1.f + __expf(-fabsf(x))); }

__device__ __forceinline__ void gla_za_load(const Frame& F, f32x4 (&za)[4], int c) {
    const int fr = F.lane & 15, fq = F.lane >> 4, dir = F.wave & 1;
    const float* g = (const float*)(F.ws + WS_GATES) + (size_t)(c * 64 + fr) * 32 + dir * 16 + fq * 4;
#pragma unroll
    for (int it = 0; it < 4; ++it) za[it] = *(const f32x4*)(g + it * 16 * 32);
}
template <bool MODEC>
__device__ __forceinline__ void gla_item(const Frame& F, f32x4 (&za)[4], const float (&wq)[4], const float bias, int c, int h, int l, bool has_next, int c_next) {
    LAS unsigned char* lds = F.lds;
    LAS float* RS = (LAS float*)(lds + GL_RS);
    const int tid = F.tid, wv = F.wave, fr = F.lane & 15, fq = F.lane >> 4;
    const int dir = wv & 1, d = (wv >> 1) * 16 + fr;
    const int token0 = c * 64;
    const bf16_t* Q = (const bf16_t*)(F.ws + WS_Q); const bf16_t* Kb = (const bf16_t*)(F.ws + WS_K);
    const bf16_t* V = (const bf16_t*)(F.ws + WS_V); bf16_t* KV = (bf16_t*)(F.ws + WS_KV); float* DEC = (float*)(F.ws + WS_DEC);
    unsigned short kraw[16], qraw[MODEC ? 16 : 1], vraw[16];
    {
        const bf16_t* kp = Kb + (size_t)(token0 + fq * 4) * 256 + h * 64 + d;
#pragma unroll
        for (int it = 0; it < 4; ++it)
#pragma unroll
            for (int j = 0; j < 4; ++j) kraw[it * 4 + j] = kp[(it * 16 + j) * 256];
        if (MODEC) { const bf16_t* qp = Q + (size_t)(token0 + fq * 4) * 256 + h * 64 + d;
#pragma unroll
            for (int it = 0; it < 4; ++it)
#pragma unroll
                for (int j = 0; j < 4; ++j) qraw[it * 4 + j] = qp[(it * 16 + j) * 256]; }
        const bf16_t* vp = V + (size_t)(token0 + (tid >> 7) * 16) * 512 + h * 128 + (tid & 127);
#pragma unroll
        for (int jj = 0; jj < 16; ++jj) vraw[jj] = vp[jj * 512];
    }
    u32x4 st4[MODEC ? 4 : 1];
    if (MODEC) { const u32x4* src = (const u32x4*)(KV + (size_t)((c * 4 + h) * 2) * 8192);
#pragma unroll
        for (int e = 0; e < 4; ++e) st4[e] = src[tid + 512 * e]; }
    float b[16];
#pragma unroll
    for (int it = 0; it < 4; ++it) { f32x4 acc = {bias, bias, bias, bias};
#pragma unroll
        for (int ks = 0; ks < 4; ++ks) acc = __builtin_amdgcn_mfma_f32_16x16x4f32(za[it][ks], wq[ks], acc, 0, 0, 0);
#pragma unroll
        for (int j = 0; j < 4; ++j) b[it * 4 + j] = logsig(acc[j]) * 0.0625f; }
    float blast = 0.f;
    if (dir == 0) {
#pragma unroll
        for (int it = 0; it < 4; ++it) {
            b[it * 4 + 1] += b[it * 4]; b[it * 4 + 2] += b[it * 4 + 1]; b[it * 4 + 3] += b[it * 4 + 2];
            const float sgl = b[it * 4 + 3]; float t = sgl;
            float u = __shfl_up(t, 16); if (fq >= 1) t += u;
            u = __shfl_up(t, 32); if (fq >= 2) t += u;
            const float tt = __shfl(t, 48 + fr); const float off = blast + (t - sgl);
#pragma unroll
            for (int j = 0; j < 4; ++j) b[it * 4 + j] += off;
            blast += tt; }
    } else {
#pragma unroll
        for (int it = 3; it >= 0; --it) {
            b[it * 4 + 2] += b[it * 4 + 3]; b[it * 4 + 1] += b[it * 4 + 2]; b[it * 4] += b[it * 4 + 1];
            const float sgl = b[it * 4]; float t = sgl;
            float u = __shfl_down(t, 16); if (fq <= 2) t += u;
            u = __shfl_down(t, 32); if (fq <= 1) t += u;
            const float tt = __shfl(t, fr); const float off = blast + (t - sgl);
#pragma unroll
            for (int j = 0; j < 4; ++j) b[it * 4 + j] += off;
            blast += tt; }
    }
    {
        const int dv = tid & 127, jg = tid >> 7; unsigned pk[8];
#pragma unroll
        for (int jj = 0; jj < 16; jj += 2) pk[jj >> 1] = (unsigned)vraw[jj] | ((unsigned)vraw[jj + 1] << 16);
        LAS u32x4* dst = (LAS u32x4*)(lds + GL_VT + (dv * 72 + jg * 16) * 2);
        dst[0] = (u32x4){pk[0], pk[1], pk[2], pk[3]}; dst[1] = (u32x4){pk[4], pk[5], pk[6], pk[7]};
        if (MODEC) {
#pragma unroll
            for (int e = 0; e < 4; ++e) { const int ch = tid + 512 * e; const int ds = ch >> 10, dvv = (ch >> 3) & 127, d8 = ch & 7;
                *(LAS u32x4*)(lds + GL_ST + ((ds * 128 + dvv) * 72 + d8 * 8) * 2) = st4[e]; }
        }
    }
    if (MODEC) {
        LAS bf16_t* QT = (LAS bf16_t*)(lds + GL_QT); LAS bf16_t* KT = (LAS bf16_t*)(lds + GL_KT);
#pragma unroll
        for (int it = 0; it < 4; ++it)
#pragma unroll
            for (int j = 0; j < 4; ++j) { const int i = it * 16 + fq * 4 + j; const float bb_ = b[it * 4 + j];
                const unsigned pk = cvt_pk_bf16(bf2f(qraw[it * 4 + j]) * __expf(bb_), bf2f(kraw[it * 4 + j]) * __expf(-bb_));
                QT[(dir * 64 + i) * 72 + d] = (bf16_t)(pk & 0xffffu); KT[(dir * 64 + i) * 72 + d] = (bf16_t)(pk >> 16); }
    } else {
#pragma unroll
        for (int it = 0; it < 4; ++it) { u32x2 o;
            o.x = cvt_pk_bf16(bf2f(kraw[it * 4 + 0]) * __expf(blast - b[it * 4 + 0]), bf2f(kraw[it * 4 + 1]) * __expf(blast - b[it * 4 + 1]));
            o.y = cvt_pk_bf16(bf2f(kraw[it * 4 + 2]) * __expf(blast - b[it * 4 + 2]), bf2f(kraw[it * 4 + 3]) * __expf(blast - b[it * 4 + 3]));
            *(LAS u32x2*)(lds + GL_X + ((dir * 64 + d) * 72 + it * 16 + fq * 4) * 2) = o; }
        if (fq == 0) DEC[(size_t)((c * 4 + h) * 2 + dir) * 64 + d] = __expf(blast);
    }
    __syncthreads();
    if (has_next) gla_za_load(F, za, c_next);
    if (!MODEC) {
        const int dw = wv & 1, dvp = wv >> 1;
        bf16x8 a[4][2], bb[2][2];
#pragma unroll
        for (int td = 0; td < 4; ++td)
#pragma unroll
            for (int kk = 0; kk < 2; ++kk) a[td][kk] = *(const LAS bf16x8*)(lds + GL_X + ((dw * 64 + (td >> 1) * 32 + 8 * (fr >> 2) + 4 * (td & 1) + (fr & 3)) * 72 + kk * 32 + fq * 8) * 2);
#pragma unroll
        for (int tv = 0; tv < 2; ++tv)
#pragma unroll
            for (int kk = 0; kk < 2; ++kk) bb[tv][kk] = *(const LAS bf16x8*)(lds + GL_VT + ((dvp * 32 + tv * 16 + fr) * 72 + kk * 32 + fq * 8) * 2);
        bf16_t* kvo = KV + (size_t)((c * 4 + h) * 2 + dw) * 8192;
#pragma unroll
        for (int p = 0; p < 2; ++p)
#pragma unroll
            for (int tv = 0; tv < 2; ++tv) { f32x4 acc0 = {0.f, 0.f, 0.f, 0.f}, acc1 = acc0;
#pragma unroll
                for (int kk = 0; kk < 2; ++kk) { acc0 = __builtin_amdgcn_mfma_f32_16x16x32_bf16(a[2 * p][kk], bb[tv][kk], acc0, 0, 0, 0);
                    acc1 = __builtin_amdgcn_mfma_f32_16x16x32_bf16(a[2 * p + 1][kk], bb[tv][kk], acc1, 0, 0, 0); }
                u32x4 o; o.x = cvt_pk_bf16(acc0[0], acc0[1]); o.y = cvt_pk_bf16(acc0[2], acc0[3]); o.z = cvt_pk_bf16(acc1[0], acc1[1]); o.w = cvt_pk_bf16(acc1[2], acc1[3]);
                *(u32x4*)(kvo + (size_t)(dvp * 32 + tv * 16 + fr) * 64 + p * 32 + 8 * fq) = o; }
        __syncthreads();
    } else {
        {
            const int dw = wv & 1, ti = wv >> 1;
            bf16x8 bq[2];
#pragma unroll
            for (int kk = 0; kk < 2; ++kk) bq[kk] = *(const LAS bf16x8*)(lds + GL_QT + ((dw * 64 + ti * 16 + fr) * 72 + kk * 32 + fq * 8) * 2);
            const int i = ti * 16 + fr;
#pragma unroll
            for (int tj = 0; tj < 4; ++tj) { f32x4 acc = {0.f, 0.f, 0.f, 0.f};
#pragma unroll
                for (int kk = 0; kk < 2; ++kk) { const bf16x8 ak = *(const LAS bf16x8*)(lds + GL_KT + ((dw * 64 + tj * 16 + fr) * 72 + kk * 32 + fq * 8) * 2);
                    acc = __builtin_amdgcn_mfma_f32_16x16x32_bf16(ak, bq[kk], acc, 0, 0, 0); }
#pragma unroll
                for (int jj = 0; jj < 4; ++jj) { const int j = tj * 16 + fq * 4 + jj; const bool keep = dw == 0 ? (j <= i) : (j >= i); if (!keep) acc[jj] = 0.f; }
                u32x2 o; o.x = cvt_pk_bf16(acc[0], acc[1]); o.y = cvt_pk_bf16(acc[2], acc[3]);
                *(LAS u32x2*)(lds + GL_X + ((dw * 64 + i) * 72 + tj * 16 + fq * 4) * 2) = o; }
        }
        const int ti = wv & 3, dvh = wv >> 2, i = ti * 16 + fr;
        const bf16_t* SG = (const bf16_t*)(F.ws + WS_SG); bf16_t* A2 = (bf16_t*)(F.ws + WS_A2);
        u32x4 sgv[2]; f32x4 gv[4];
#pragma unroll
        for (int p = 0; p < 2; ++p) { const int dv0 = dvh * 64 + p * 32 + 8 * fq;
            gv[2 * p] = *(const f32x4*)(F.in[IN_GGLA] + l * 128 + dv0); gv[2 * p + 1] = *(const f32x4*)(F.in[IN_GGLA] + l * 128 + dv0 + 4);
            sgv[p] = *(const u32x4*)(SG + (size_t)(token0 + i) * 512 + h * 128 + dv0); }
        __syncthreads();
        f32x4 o[4];
        {
            bf16x8 batt[2][2], bqt[2][2];
#pragma unroll
            for (int ds = 0; ds < 2; ++ds)
#pragma unroll
                for (int kk = 0; kk < 2; ++kk) { batt[ds][kk] = *(const LAS bf16x8*)(lds + GL_X + ((ds * 64 + i) * 72 + kk * 32 + fq * 8) * 2);
                    bqt[ds][kk] = *(const LAS bf16x8*)(lds + GL_QT + ((ds * 64 + i) * 72 + kk * 32 + fq * 8) * 2); }
#pragma unroll
            for (int t = 0; t < 4; ++t) { const int vrow = dvh * 64 + (t >> 1) * 32 + 8 * (fr >> 2) + 4 * (t & 1) + (fr & 3); f32x4 acc = {0.f, 0.f, 0.f, 0.f};
#pragma unroll
                for (int kk = 0; kk < 2; ++kk) { const bf16x8 av = *(const LAS bf16x8*)(lds + GL_VT + (vrow * 72 + kk * 32 + fq * 8) * 2);
#pragma unroll
                    for (int ds = 0; ds < 2; ++ds) { acc = __builtin_amdgcn_mfma_f32_16x16x32_bf16(av, batt[ds][kk], acc, 0, 0, 0);
                        const bf16x8 as = *(const LAS bf16x8*)(lds + GL_ST + ((ds * 128 + vrow) * 72 + kk * 32 + fq * 8) * 2);
                        acc = __builtin_amdgcn_mfma_f32_16x16x32_bf16(as, bqt[ds][kk], acc, 0, 0, 0); } }
                o[t] = acc; }
        }
        float ss = 0.f;
#pragma unroll
        for (int t = 0; t < 4; ++t) ss += (o[t][0] * o[t][0] + o[t][1] * o[t][1]) + (o[t][2] * o[t][2] + o[t][3] * o[t][3]);
        ss += __shfl_xor(ss, 16); ss += __shfl_xor(ss, 32);
        if (fq == 0) RS[dvh * 64 + i] = ss;
        __syncthreads();
        const float rn = __builtin_amdgcn_rsqf((RS[i] + RS[64 + i]) * (1.f / 128.f) + EPS);
#pragma unroll
        for (int p = 0; p < 2; ++p) { const int dv0 = dvh * 64 + p * 32 + 8 * fq;
            const f32x4 v0 = o[2 * p] * rn * gv[2 * p], v1 = o[2 * p + 1] * rn * gv[2 * p + 1]; const u32x4 sg = sgv[p];
            u32x4 wo; wo.x = cvt_pk_bf16(v0[0] * silu_f(bf2f(sg.x & 0xffffu)), v0[1] * silu_f(bf2f(sg.x >> 16))); wo.y = cvt_pk_bf16(v0[2] * silu_f(bf2f(sg.y & 0xffffu)), v0[3] * silu_f(bf2f(sg.y >> 16)));
            wo.z = cvt_pk_bf16(v1[0] * silu_f(bf2f(sg.z & 0xffffu)), v1[1] * silu_f(bf2f(sg.z >> 16))); wo.w = cvt_pk_bf16(v1[2] * silu_f(bf2f(sg.w & 0xffffu)), v1[3] * silu_f(bf2f(sg.w >> 16)));
            *(u32x4*)(A2 + (size_t)(token0 + i) * KOUT + 1024 + h * 128 + dv0) = wo; }
        __syncthreads();
    }
}

__device__ __forceinline__ void scan_phase(const Frame& F, int l) {
    bf16_t* KV = (bf16_t*)(F.ws + WS_KV); const float* DEC = (const float*)(F.ws + WS_DEC);
    float* ostate = F.out + (size_t)MTOK * DM;
    const int half = F.tid >> 8, t = F.tid & 255;
    if (half == 0) {
        for (int it = F.bid; it < 256; it += F.G) {
            const int chain = it >> 3, eb = it & 7, dir = chain & 1, h = (chain >> 1) & 3, bq = chain >> 3, c0 = 128 + 32 * bq;
            const int e = eb * 1024 + t * 4, dv = e >> 6, dk = e & 63;
            const float* sp = F.in[IN_STATE] + ((size_t)(((bq * 2 + l) * 2 + dir) * 4 + h) * 64 + dk) * 128 + dv;
            f32x4 sv = {sp[0], sp[128], sp[256], sp[384]};
            for (int n0 = 0; n0 < 32; n0 += 8) {
                u32x2 kv[8]; f32x4 dc[8];
#pragma unroll
                for (int u = 0; u < 8; ++u) { const int n = dir == 0 ? n0 + u : 31 - (n0 + u); const size_t idx = (size_t)((c0 + n) * 4 + h) * 2 + dir;
                    kv[u] = *(const u32x2*)(KV + idx * 8192 + e); dc[u] = *(const f32x4*)(DEC + idx * 64 + dk); }
#pragma unroll
                for (int u = 0; u < 8; ++u) { const int n = dir == 0 ? n0 + u : 31 - (n0 + u); const size_t idx = (size_t)((c0 + n) * 4 + h) * 2 + dir;
                    u32x2 o; o.x = cvt_pk_bf16(sv[0], sv[1]); o.y = cvt_pk_bf16(sv[2], sv[3]); *(u32x2*)(KV + idx * 8192 + e) = o;
                    const f32x4 kf = {bf2f(kv[u].x & 0xffffu), bf2f(kv[u].x >> 16), bf2f(kv[u].y & 0xffffu), bf2f(kv[u].y >> 16)};
                    sv = dc[u] * sv + kf; }
            }
        }
    } else {
        for (int p0 = F.bid; p0 < 1024; p0 += 2 * F.G) {
            u32x4 kv[2][4]; f32x4 dc[2][4][2];
#pragma unroll
            for (int q = 0; q < 2; ++q) { const int p = p0 + q * F.G; if (p < 1024) { const int chain = p >> 2, qt = p & 3, dir = chain & 1, h = (chain >> 1) & 3, bq = chain >> 3;
                const int e = qt * 2048 + t * 8, dk = e & 63;
#pragma unroll
                for (int u = 0; u < 4; ++u) { const int n = dir == 0 ? u : 3 - u; const size_t idx = (size_t)((4 * bq + n) * 4 + h) * 2 + dir;
                    kv[q][u] = *(const u32x4*)(KV + idx * 8192 + e); dc[q][u][0] = *(const f32x4*)(DEC + idx * 64 + dk); dc[q][u][1] = *(const f32x4*)(DEC + idx * 64 + dk + 4); } } }
#pragma unroll
            for (int q = 0; q < 2; ++q) { const int p = p0 + q * F.G; if (p < 1024) { const int chain = p >> 2, qt = p & 3, dir = chain & 1, h = (chain >> 1) & 3, bq = chain >> 3;
                const int e = qt * 2048 + t * 8, dv = e >> 6, dk = e & 63;
                float z0_ = 0.f; asm volatile("" : "+v"(z0_));
                f32x4 s0 = {z0_, z0_, z0_, z0_}, s1 = s0;
#pragma unroll
                for (int u = 0; u < 4; ++u) { const int n = dir == 0 ? u : 3 - u; const size_t idx = (size_t)((4 * bq + n) * 4 + h) * 2 + dir;
                    u32x4 o; o.x = cvt_pk_bf16(s0[0], s0[1]); o.y = cvt_pk_bf16(s0[2], s0[3]); o.z = cvt_pk_bf16(s1[0], s1[1]); o.w = cvt_pk_bf16(s1[2], s1[3]);
                    *(u32x4*)(KV + idx * 8192 + e) = o;
                    const u32x4 k4 = kv[q][u];
                    const f32x4 k0 = {bf2f(k4.x & 0xffffu), bf2f(k4.x >> 16), bf2f(k4.y & 0xffffu), bf2f(k4.y >> 16)}, k1 = {bf2f(k4.z & 0xffffu), bf2f(k4.z >> 16), bf2f(k4.w & 0xffffu), bf2f(k4.w >> 16)};
                    s0 = dc[q][u][0] * s0 + k0; s1 = dc[q][u][1] * s1 + k1; }
                float* op = ostate + ((size_t)(((bq * 2 + l) * 2 + dir) * 4 + h) * 64 + dk) * 128 + dv;
                op[0] = s0[0]; op[128] = s0[1]; op[256] = s0[2]; op[384] = s0[3]; op[512] = s1[0]; op[640] = s1[1]; op[768] = s1[2]; op[896] = s1[3]; } }
        }
    }
}


#define XB_TMO      128
#define XB_XCNT(j)  (256  + 64 * (j))
#define XB_XSUB(j)  (1280 + 64 * (j))
#define XB_XGEN(j)  (2304 + 64 * (j))
#define XB_TOP      3328
#define XB_TOPGEN   3392
#define XCD_BAR_WORDS 3456
#define XB_SPIN_CAP (1u << 22)
__device__ __forceinline__ unsigned xb_ld(unsigned* p)              { return __hip_atomic_load(p, __ATOMIC_RELAXED, __HIP_MEMORY_SCOPE_AGENT); }
__device__ __forceinline__ unsigned xb_add(unsigned* p, unsigned v) { return __hip_atomic_fetch_add(p, v, __ATOMIC_RELAXED, __HIP_MEMORY_SCOPE_AGENT); }
__device__ __forceinline__ unsigned xb_xcc_id() { return (unsigned)__builtin_amdgcn_s_getreg((3 << 11) | 20) & 0xFu; }
#define XB_SPIN(cond, bar) do { unsigned _sp = 0; while (cond) { __builtin_amdgcn_s_sleep(1); \
    if ((++_sp & 255u) == 0u) { if (xb_ld(&(bar)[XB_TMO])) break; if (_sp > XB_SPIN_CAP) { atomicAdd(&(bar)[XB_TMO], 1u); break; } } } } while (0)
struct XcdBarrier { unsigned* bar; unsigned x; volatile LAS unsigned* st; };
__device__ __forceinline__ XcdBarrier xcd_barrier_post(unsigned* bar, volatile LAS unsigned* st) {
    XcdBarrier b; b.bar = bar; b.x = xb_xcc_id(); b.st = st;
    if (threadIdx.x == 0) (void)xb_add(&bar[XB_XCNT(b.x)], 1u);
    return b;
}
__device__ __forceinline__ void xcd_barrier_complete(unsigned* bar, unsigned x, unsigned& nloc, unsigned& nx) {
    const unsigned G = gridDim.x * gridDim.y * gridDim.z;
    unsigned sum, cnt, mine, sp = 0u;
    for (;;) {
        sum = 0u; cnt = 0u; mine = 0u;
#pragma unroll
        for (unsigned j = 0; j < 16; ++j) { const unsigned c = xb_ld(&bar[XB_XCNT(j)]); sum += c; cnt += (c > 0u) ? 1u : 0u; mine = (j == x) ? c : mine; }
        if (sum == G) break;
        __builtin_amdgcn_s_sleep(1);
        if ((++sp & 255u) == 0u) { if (xb_ld(&bar[XB_TMO])) break; if (sp > XB_SPIN_CAP) { atomicAdd(&bar[XB_TMO], 1u); break; } }
    }
    nloc = mine > 0u ? mine : 1u; nx = cnt > 0u ? cnt : 1u;
}
__device__ __forceinline__ void xcd_barrier(const XcdBarrier& b) {
    asm volatile("s_waitcnt vmcnt(0)" ::: "memory");
    __syncthreads();
    if (threadIdx.x == 0) {
        unsigned* bar = b.bar;
        __builtin_amdgcn_s_waitcnt(0);
        unsigned nloc = b.st[0], nx = b.st[1];
        if (nloc == 0u) { xcd_barrier_complete(bar, b.x, nloc, nx); b.st[0] = nloc; b.st[1] = nx; }
        const unsigned old = xb_add(&bar[XB_XSUB(b.x)], 1u);
        const unsigned gen = old / nloc;
        if (old + 1u == (gen + 1u) * nloc) {
            __builtin_amdgcn_fence(__ATOMIC_RELEASE, "agent");
            asm volatile("s_waitcnt vmcnt(0)" ::: "memory");
            const unsigned og = xb_add(&bar[XB_TOP], 1u);
            const unsigned tg = og / nx;
            if (og + 1u == (tg + 1u) * nx) xb_add(&bar[XB_TOPGEN], 1u);
            else XB_SPIN(xb_ld(&bar[XB_TOPGEN]) == tg, bar);
            __builtin_amdgcn_fence(__ATOMIC_ACQUIRE, "agent");
            xb_add(&bar[XB_XGEN(b.x)], 1u);
            asm volatile("s_waitcnt vmcnt(0)" ::: "memory");
        } else {
            XB_SPIN(xb_ld(&bar[XB_XGEN(b.x)]) == gen, bar);
            __builtin_amdgcn_fence(__ATOMIC_ACQUIRE, "agent");
            asm volatile("s_waitcnt vmcnt(0)" ::: "memory");
        }
    }
    __syncthreads();
}

__global__ void __launch_bounds__(512, 2) mk_fwd(Args args) {
    extern __shared__ __attribute__((aligned(16))) unsigned char lds_raw[];
    cg::grid_group grid = cg::this_grid();
    Frame F0; {Frame& F = F0;
    F.lds = (LAS unsigned char*)lds_raw; F.tid = threadIdx.x; F.lane = F.tid & 63; F.wave = __builtin_amdgcn_readfirstlane(F.tid >> 6);
    F.G = gridDim.x; F.bid = blockIdx.x; F.in = args.in; F.out = args.out; F.ws = args.ws; }
#define OPAQ_S(x) asm volatile("" : "+s"(x))
#define PHASE_FRAME(lv) Frame F = F0; { int w_ = F0.wave; OPAQ_S(w_); int ln_; asm volatile("v_mbcnt_lo_u32_b32 %0, -1, 0\n\tv_mbcnt_hi_u32_b32 %0, -1, %0" : "=v"(ln_)); F.tid = w_ * 64 + ln_; } asm volatile("" : "+v"(F.tid)); F.lane = F.tid & 63; F.wave = __builtin_amdgcn_readfirstlane(F.tid >> 6); { size_t z_ = 0; OPAQ_S(z_); F.ws = args.ws + z_; F.out = args.out + z_; } OPAQ_S(F.G); OPAQ_S(F.bid); int l = (lv); OPAQ_S(l); unsigned char* ws = F.ws; (void)ws; (void)l;
#ifndef PHM
#define PHM 0xFFFF
#endif
    unsigned* barw = (unsigned*)(args.ws + WS_BAR);
    volatile LAS unsigned* bst = (volatile LAS unsigned*)((LAS unsigned char*)lds_raw + MISC_OFF);
    if (threadIdx.x < 2) bst[threadIdx.x] = 0u;
    __syncthreads();
    XcdBarrier xbar = xcd_barrier_post(barw, bst);
    if (args.ph_hi < 0) grid.sync();
    int ph = 0;
#define RUN(k) ((k) >= args.ph_lo && (k) < args.ph_hi)
#define SEAM() do { if (ph + 1 < args.ph_hi && ph >= args.ph_lo) { XcdBarrier xb_ = xbar; size_t z_ = 0; OPAQ_S(z_); xb_.bar = barw + z_; xcd_barrier(xb_); } ++ph; } while (0)
    if (RUN(ph) && (PHM & 1)) { PHASE_FRAME(0) prep_gemv(F); }
    SEAM();
    if (RUN(ph) && (PHM & 2)) { PHASE_FRAME(0) prep_rest(F); }
    SEAM();
    for (int l0 = 0; l0 < DEPTH; ++l0) {
        if (RUN(ph) && (PHM & 4)) { PHASE_FRAME(l0)
            pg8::TileOrder S; S.init(ws + WS_H, ws + WS_WIN + (size_t)l * N1 * 1024 * 2, MTOK, 2048, 1024, 1024, F.G, F.bid);
            EpiIn E{(bf16_t*)(ws + WS_ZT), (bf16_t*)(ws + WS_Q), (bf16_t*)(ws + WS_K), (bf16_t*)(ws + WS_V), (bf16_t*)(ws + WS_SG), (float*)(ws + WS_GATES)};
            pg8::gemm_phase<EpiIn, pg8::TileOrder, true, 1024, 1024>(F.lds, F.tid, S, E);
            for (int rt = F.bid; rt < MTOK / 64; rt += F.G) gate_rows(F.lds, F.tid, rt * 64, (const bf16_t*)(ws + WS_H), (const bf16_t*)(ws + WS_WIN) + ((size_t)l * N1 + 2048) * 1024, (float*)(ws + WS_GATES));
        }
        SEAM();
        if (RUN(ph) && (PHM & 8)) { PHASE_FRAME(l0)
            const int Gh = F.G >> 1; EpiStore E{};
            const bool smp = F.bid < Gh;
            DftOrder S{(const char*)(ws + (smp ? WS_DS : WS_DC)), (const char*)(ws + WS_ZT + (smp ? 8 * MiB : 0)), (char*)(ws + WS_A2), smp ? Gh : F.G - Gh, smp ? F.bid : F.bid - Gh, smp};
            if (smp) pg8::gemm_phase<EpiStore, DftOrder, true, 2048, 2048>(F.lds, F.tid, S, E);
            else pg8::gemm_phase<EpiStore, DftOrder, true, 256, 256>(F.lds, F.tid, S, E);
            __syncthreads();
            if (!smp) {
                const int nb = F.G - Gh, b0 = F.bid - Gh, lo = 0, hi = 1024;
                const int h_ = (lo + b0) & 3; float wq_[4]; float bias_; f32x4 za_[4];
                { const int d_ = (F.wave >> 1) * 16 + (F.lane & 15), dir_ = F.wave & 1, fq_ = F.lane >> 4; const float* wg = F.in[dir_ ? IN_WGB : IN_WGF] + l * 16 * 256 + h_ * 64 + d_;
#pragma unroll
                  for (int ks = 0; ks < 4; ++ks) wq_[ks] = wg[(fq_ * 4 + ks) * 256];
                  bias_ = F.in[dir_ ? IN_BGB : IN_BGF][l * 256 + h_ * 64 + d_]; }
                int it = lo + b0; gla_za_load(F, za_, (it < hi ? it : hi - 1) >> 2);
                for (; it < hi; it += nb) gla_item<false>(F, za_, wq_, bias_, it >> 2, h_, l, it + nb < hi, (it + nb) >> 2);
            }
        }
        SEAM();
        if (RUN(ph) && (PHM & 16)) { PHASE_FRAME(l0) scan_phase(F, l); }
        SEAM();
        if (RUN(ph) && (PHM & 32)) { PHASE_FRAME(l0) const int h_ = F.bid & 3; float wq_[4]; float bias_; f32x4 za_[4];
            { const int d_ = (F.wave >> 1) * 16 + (F.lane & 15), dir_ = F.wave & 1, fq_ = F.lane >> 4; const float* wg = F.in[dir_ ? IN_WGB : IN_WGF] + l * 16 * 256 + h_ * 64 + d_;
#pragma unroll
              for (int ks = 0; ks < 4; ++ks) wq_[ks] = wg[(fq_ * 4 + ks) * 256];
              bias_ = F.in[dir_ ? IN_BGB : IN_BGF][l * 256 + h_ * 64 + d_]; }
            int it = F.bid; gla_za_load(F, za_, (it < 1024 ? it : 1023) >> 2);
            for (; it < 1024; it += F.G) gla_item<true>(F, za_, wq_, bias_, it >> 2, h_, l, it + F.G < 1024, (it + F.G) >> 2); }
        SEAM();
        if (RUN(ph) && (PHM & 64)) { PHASE_FRAME(l0)
            pg8::TileOrder S; S.init(ws + WS_A2, ws + WS_WOUT + (size_t)l * 1024 * KOUT * 2, MTOK, 1024, KOUT, KOUT, F.G, F.bid);
            EpiRows E{nullptr, (bf16_t*)(ws + WS_XRB), (bf16_t*)(ws + WS_H), (const float*)(ws + WS_MOD), F.in[IN_GQM] + l * 1024, F.in[IN_GPF] + l * 1024, l, 2, l, 4, 3, true,
                      (unsigned*)(ws + WS_XBUF) + (size_t)(l * 2 + 0) * 2 * 64 * 1024, (unsigned*)(ws + WS_XCNT) + (size_t)(l * 2 + 0) * 2 * 64 * 64};
            pg8::gemm_phase<EpiRows, pg8::TileOrder, true, KOUT, KOUT>(F.lds, F.tid, S, E);
        }
        SEAM();
        if (RUN(ph) && (PHM & 256)) { PHASE_FRAME(l0)
            pg8::TileOrder S; S.init(ws + WS_H, ws + WS_WUP + (size_t)l * NUP * 1024 * 2, MTOK, NUP, 1024, 1024, F.G, F.bid);
            EpiConv E{(bf16_t*)(ws + WS_ACT), F.in[IN_CW] + (size_t)l * 3 * NUP, F.in[IN_CB] + (size_t)l * NUP};
            pg8::gemm_phase<EpiConv, pg8::TileOrder, true, 1024, 1024>(F.lds, F.tid, S, E);
        }
        SEAM();
        if (RUN(ph) && (PHM & 512)) { PHASE_FRAME(l0)
            pg8::TileOrder S; S.init(ws + WS_ACT, ws + WS_WDN + (size_t)l * 1024 * DFF * 2, MTOK, 1024, DFF, DFF, F.G, F.bid);
            const int ln = l + 1 < DEPTH ? l + 1 : l;
            EpiRows E{l + 1 < DEPTH ? nullptr : F.out, (bf16_t*)(ws + WS_XRB), (bf16_t*)(ws + WS_H), (const float*)(ws + WS_MOD), F.in[IN_GQF] + l * 1024, F.in[IN_GPM] + ln * 1024, l, 5, ln, 1, 0, l + 1 < DEPTH,
                      (unsigned*)(ws + WS_XBUF) + (size_t)(l * 2 + 1) * 2 * 64 * 1024, (unsigned*)(ws + WS_XCNT) + (size_t)(l * 2 + 1) * 2 * 64 * 64};
            pg8::gemm_phase<EpiRows, pg8::TileOrder, true, DFF, DFF>(F.lds, F.tid, S, E);
        }
        SEAM();
    }
#undef RUN
#undef SEAM
}
constexpr int N_PHASES = 2 + 7 * DEPTH;
__global__ void dbg_copy(const unsigned short* src, float* out, size_t n) { for (size_t i = blockIdx.x * (size_t)blockDim.x + threadIdx.x; i < n; i += (size_t)gridDim.x * blockDim.x) out[i] = __uint_as_float((unsigned)src[i] << 16); }
__global__ void dbg_copyf(const float* src, float* out, size_t n) { for (size_t i = blockIdx.x * (size_t)blockDim.x + threadIdx.x; i < n; i += (size_t)gridDim.x * blockDim.x) out[i] = src[i]; }

#ifndef MK_LAST
#define MK_LAST (N_PHASES - 1)
#endif
#ifndef MK_MULTI
#define MK_MULTI 0
#endif
extern "C" void kernel_launch(void* const* d_in, const int* in_sizes, int n_in, void* d_out, int out_size, void* d_ws, size_t ws_size, hipStream_t stream) {
    static int grid = 0;
    if (grid == 0) {
        if (n_in != 22 || ws_size < WS_END) { fprintf(stderr, "kernel_launch: unexpected inputs (n_in %d, ws %zu)\n", n_in, ws_size); grid = -1; return; }
        int dev = 0, cus = 0, per_cu = 0;
        hipGetDevice(&dev); hipDeviceGetAttribute(&cus, hipDeviceAttributeMultiprocessorCount, dev);
        hipFuncSetAttribute((const void*)mk_fwd, hipFuncAttributeMaxDynamicSharedMemorySize, LDS_BYTES);
        if (hipOccupancyMaxActiveBlocksPerMultiprocessor(&per_cu, (const void*)mk_fwd, 512, LDS_BYTES) != hipSuccess || per_cu < 1) { fprintf(stderr, "kernel_launch: occupancy query says %d blocks/CU\n", per_cu); per_cu = 1; }
        (void)hipGetLastError();
        grid = cus;
        if (grid & 1) grid -= 1;
    }
    if (grid < 0) return;
    if (hipMemsetAsync((char*)d_ws + WS_BAR, 0, 256 * 1024, stream) != hipSuccess) fprintf(stderr, "memset of barrier words failed\n");
    Args a{};
    for (int i = 0; i < 22; ++i) a.in[i] = (const float*)d_in[i];
    a.out = (float*)d_out; a.ws = (unsigned char*)d_ws;
#if MK_MULTI
    for (int p = 0; p < MK_LAST + 1; ++p) { a.ph_lo = p; a.ph_hi = p + 1; hipLaunchKernelGGL(mk_fwd, dim3(grid), dim3(512), LDS_BYTES, stream, a); }
#ifdef MK_DBG
    MK_DBG
#endif
#else
    a.ph_lo = 0; a.ph_hi = N_PHASES;
    void* kargs[] = {&a};
    hipError_t e = hipLaunchCooperativeKernel((const void*)mk_fwd, dim3(grid), dim3(512), kargs, LDS_BYTES, stream);
    if (e != hipSuccess) fprintf(stderr, "cooperative launch failed: %s (grid %d)\n", hipGetErrorString(e), grid);
#endif
}
```
